# Optimizing an MI355X kernel written in HIP

```python
import math
import jax
import jax.numpy as jnp
from jax import lax
import numpy as np

D_MODEL = 1024
BATCH = 16
SEQ = 4096
DEPTH = 1
DEC_BATCH = 8
DEC_SEQ = 16
PAST_LEN = 4096

CHUNK = 64
A_PREV_CHUNKS = 8
A_PAST = A_PREV_CHUNKS * CHUNK
A_HEADS = 8
A_HEAD_DIM = 64
REL_CLIP = 128
B_HEADS = 4
B_HEAD_DIM = 64
B_V_DIM = 2 * B_HEAD_DIM
M_HEADS = 4
M_HEAD_DIM = 128
N_MEM = 256
BRANCH_W = 512
N_BRANCH = 3
IN_SPLITS = (BRANCH_W,) * 10 + (N_BRANCH * D_MODEL,)
D_IN = 10 * BRANCH_W + N_BRANCH * D_MODEL
ROPE_THETA = 10000.0
RMS_EPS = 1e-6
Q_BLOCK = 128
NEG_INF = -1e30

kernel_name = 'hybrid_chunk_diff_mem_encoder_step'


def rmsnorm(x, g):
    xf = x.astype(jnp.float32)
    xf = xf * lax.rsqrt(jnp.mean(xf * xf, axis=-1, keepdims=True) + RMS_EPS)
    return (xf * g.astype(jnp.float32)).astype(x.dtype)


def rope(x, pos):
    d = x.shape[-1]
    inv = 1.0 / (ROPE_THETA ** (jnp.arange(0, d, 2, dtype=jnp.float32) / d))
    ang = pos.astype(jnp.float32)[:, None] * inv[None, :]
    cos = jnp.cos(ang)[:, None, :]
    sin = jnp.sin(ang)[:, None, :]
    xf = x.astype(jnp.float32)
    x1, x2 = xf[..., : d // 2], xf[..., d // 2:]
    return jnp.concatenate([x1 * cos - x2 * sin, x1 * sin + x2 * cos], axis=-1).astype(x.dtype)


def lambda_init(layer):
    return 0.8 - 0.6 * math.exp(-0.3 * layer)


def diff_lambda(lq1, lk1, lq2, lk2, lam_init):
    e = lambda a, b: jnp.exp(jnp.sum(a.astype(jnp.float32) * b.astype(jnp.float32)))
    return e(lq1, lk1) - e(lq2, lk2) + lam_init


def rel_bias_lookup(rel_bias, dist):
    idx = jnp.clip(dist, -REL_CLIP, REL_CLIP) + REL_CLIP
    return rel_bias[:, idx].astype(jnp.float32)


def project_in(x, pos, norm_in, w_in):
    b, s, _ = x.shape
    h = rmsnorm(x, norm_in)
    proj = jnp.einsum('bsd,de->bse', h, w_in)
    bounds = np.cumsum(IN_SPLITS)[:-1].tolist()
    aq, ak, av, az, bq, bk, bv, bz, mq, mz, g = jnp.split(proj, bounds, axis=-1)
    r = lambda a, nh, d: a.reshape(b, s, nh, d)
    return (r(aq, A_HEADS, A_HEAD_DIM), r(ak, A_HEADS, A_HEAD_DIM), r(av, A_HEADS, A_HEAD_DIM),
            rope(r(bq, 2 * B_HEADS, B_HEAD_DIM), pos), rope(r(bk, 2 * B_HEADS, B_HEAD_DIM), pos),
            r(bv, B_HEADS, B_V_DIM), r(mq, M_HEADS, M_HEAD_DIM), az, bz, mz, g)


def chunk_attn_prompt(q, k, v, rel_bias):
    b, s, h, d = q.shape
    n_chunks = s // CHUNK
    band = A_PAST + CHUNK
    kp = jnp.pad(k, ((0, 0), (A_PAST, 0), (0, 0), (0, 0)))
    vp = jnp.pad(v, ((0, 0), (A_PAST, 0), (0, 0), (0, 0)))
    qc = jnp.moveaxis(q.reshape(b, n_chunks, CHUNK, h, d), 1, 0)
    dist = jnp.arange(CHUNK)[:, None] + A_PAST - jnp.arange(band)[None, :]
    bias = rel_bias_lookup(rel_bias, dist)
    scale = d ** -0.5

    def one_chunk(args):
        c, qb = args
        start = c * CHUNK
        kb = lax.dynamic_slice_in_dim(kp, start, band, axis=1)
        vb = lax.dynamic_slice_in_dim(vp, start, band, axis=1)
        valid = (start - A_PAST + jnp.arange(band)) >= 0
        sc = jnp.einsum('bqhd,bkhd->bhqk', qb, kb).astype(jnp.float32) * scale + bias
        sc = jnp.where(valid, sc, NEG_INF)
        p = jax.nn.softmax(sc, axis=-1)
        return jnp.einsum('bhqk,bkhd->bqhd', p.astype(vb.dtype), vb)

    o = lax.map(one_chunk, (jnp.arange(n_chunks), qc))
    return jnp.moveaxis(o, 0, 1).reshape(b, s, h * d)


def chunk_attn_sample(q, k_new, v_new, cache_k, cache_v, rel_bias):
    b, t, h, d = q.shape
    p_len = cache_k.shape[1]
    k = jnp.concatenate([cache_k, k_new], axis=1)
    v = jnp.concatenate([cache_v, v_new], axis=1)
    kpos = jnp.concatenate([jnp.arange(p_len), p_len + jnp.arange(t)])
    dist = (p_len + jnp.arange(t))[:, None] - kpos[None, :]
    bias = rel_bias_lookup(rel_bias, dist)
    sc = jnp.einsum('bqhd,bkhd->bhqk', q, k).astype(jnp.float32) * (d ** -0.5) + bias
    p = jax.nn.softmax(sc, axis=-1)
    return jnp.einsum('bhqk,bkhd->bqhd', p.astype(v.dtype), v).reshape(b, t, h * d)


def diff_core(q, k, v, mask, lam, subln, lam_init):
    sc = jnp.einsum('bqhmd,bkhmd->bhmqk', q, k).astype(jnp.float32) * (B_HEAD_DIM ** -0.5)
    if mask is not None:
        sc = jnp.where(mask, sc, NEG_INF)
    p = jax.nn.softmax(sc, axis=-1)
    pd = p[:, :, 0] - lam * p[:, :, 1]
    o = jnp.einsum('bhqk,bkhe->bqhe', pd.astype(v.dtype), v)
    return rmsnorm(o, subln) * (1.0 - lam_init)


def diff_attn_prompt(q, k, v, lam, subln, lam_init):
    b, s = q.shape[:2]
    nq = s // Q_BLOCK
    qb = jnp.moveaxis(q.reshape(b, nq, Q_BLOCK, B_HEADS, 2, B_HEAD_DIM), 1, 0)
    k2 = k.reshape(b, s, B_HEADS, 2, B_HEAD_DIM)
    k_chunk = jnp.arange(s) // CHUNK

    def one_block(args):
        i, qblk = args
        q_chunk = (i * Q_BLOCK + jnp.arange(Q_BLOCK)) // CHUNK
        mask = k_chunk[None, :] <= q_chunk[:, None]
        return diff_core(qblk, k2, v, mask, lam, subln, lam_init)

    o = lax.map(one_block, (jnp.arange(nq), qb))
    return jnp.moveaxis(o, 0, 1).reshape(b, s, B_HEADS * B_V_DIM)


def diff_attn_sample(q, k_new, v_new, cache_k, cache_v, lam, subln, lam_init):
    b, t = q.shape[:2]
    k = jnp.concatenate([cache_k, k_new], axis=1)
    v = jnp.concatenate([cache_v, v_new], axis=1)
    n_k = k.shape[1]
    o = diff_core(q.reshape(b, t, B_HEADS, 2, B_HEAD_DIM), k.reshape(b, n_k, B_HEADS, 2, B_HEAD_DIM),
                  v, None, lam, subln, lam_init)
    return o.reshape(b, t, B_HEADS * B_V_DIM)


def memory_kv(mem, norm_mem, w_mem_kv):
    b, n, _ = mem.shape
    kv = jnp.einsum('bnd,de->bne', rmsnorm(mem, norm_mem), w_mem_kv)
    mk, mv = jnp.split(kv, 2, axis=-1)
    return mk.reshape(b, n, M_HEADS, M_HEAD_DIM), mv.reshape(b, n, M_HEADS, M_HEAD_DIM)


def mem_attn(q, mk, mv):
    b, s = q.shape[:2]
    sc = jnp.einsum('bqhd,bmhd->bhqm', q, mk).astype(jnp.float32) * (M_HEAD_DIM ** -0.5)
    p = jax.nn.softmax(sc, axis=-1)
    return jnp.einsum('bhqm,bmhd->bqhd', p.astype(mv.dtype), mv).reshape(b, s, M_HEADS * M_HEAD_DIM)


def merge_branches(o_a, z_a, o_b, z_b, o_m, z_m, g, w_ba, w_bb, w_bm, w_out):
    p_a = jnp.einsum('bse,ed->bsd', o_a * jax.nn.silu(z_a), w_ba)
    p_b = jnp.einsum('bse,ed->bsd', o_b * jax.nn.silu(z_b), w_bb)
    p_m = jnp.einsum('bse,ed->bsd', o_m * jax.nn.silu(z_m), w_bm)
    g_a, g_b, g_m = jnp.split(jax.nn.sigmoid(g), N_BRANCH, axis=-1)
    mixed = g_a * p_a + g_b * p_b + g_m * p_m
    return jnp.einsum('bsd,de->bse', mixed, w_out)


def setup_inputs(seed: int = 0) -> dict:
    key = jax.random.key(seed)
    ks = jax.random.split(key, 24)
    nrm = lambda k, shape, scale: jax.random.normal(k, shape, jnp.float32) * scale
    a_cache = min(A_PAST, PAST_LEN)
    return {
        'x_prompt': nrm(ks[0], (BATCH, SEQ, D_MODEL), 1.0),
        'x_sample': nrm(ks[1], (DEC_BATCH, DEC_SEQ, D_MODEL), 1.0),
        'cache_a_k': nrm(ks[2], (DEPTH, DEC_BATCH, a_cache, A_HEADS, A_HEAD_DIM), 1.0),
        'cache_a_v': nrm(ks[3], (DEPTH, DEC_BATCH, a_cache, A_HEADS, A_HEAD_DIM), 1.0),
        'cache_b_k': nrm(ks[4], (DEPTH, DEC_BATCH, PAST_LEN, 2 * B_HEADS, B_HEAD_DIM), 1.0),
        'cache_b_v': nrm(ks[5], (DEPTH, DEC_BATCH, PAST_LEN, B_HEADS, B_V_DIM), 1.0),
        'cache_mem_k': nrm(ks[6], (DEPTH, DEC_BATCH, N_MEM, M_HEADS, M_HEAD_DIM), 1.0),
        'cache_mem_v': nrm(ks[7], (DEPTH, DEC_BATCH, N_MEM, M_HEADS, M_HEAD_DIM), 1.0),
        'mem_prompt': nrm(ks[8], (BATCH, N_MEM, D_MODEL), 1.0),
        'norm_in': 1.0 + nrm(ks[9], (DEPTH, D_MODEL), 0.02),
        'w_in': nrm(ks[10], (DEPTH, D_MODEL, D_IN), D_MODEL ** -0.5),
        'rel_bias': nrm(ks[11], (DEPTH, A_HEADS, 2 * REL_CLIP + 1), 0.5),
        'lambda_q1': nrm(ks[12], (DEPTH, B_HEAD_DIM), 0.1),
        'lambda_k1': nrm(ks[13], (DEPTH, B_HEAD_DIM), 0.1),
        'lambda_q2': nrm(ks[14], (DEPTH, B_HEAD_DIM), 0.1),
        'lambda_k2': nrm(ks[15], (DEPTH, B_HEAD_DIM), 0.1),
        'subln': 1.0 + nrm(ks[16], (DEPTH, B_V_DIM), 0.02),
        'norm_mem': 1.0 + nrm(ks[17], (DEPTH, D_MODEL), 0.02),
        'w_mem_kv': nrm(ks[18], (DEPTH, D_MODEL, 2 * M_HEADS * M_HEAD_DIM), D_MODEL ** -0.5),
        'w_branch_a': nrm(ks[19], (DEPTH, BRANCH_W, D_MODEL), BRANCH_W ** -0.5),
        'w_branch_b': nrm(ks[20], (DEPTH, BRANCH_W, D_MODEL), BRANCH_W ** -0.5),
        'w_branch_m': nrm(ks[21], (DEPTH, BRANCH_W, D_MODEL), BRANCH_W ** -0.5),
        'w_out': nrm(ks[22], (DEPTH, D_MODEL, D_MODEL), D_MODEL ** -0.5),
        'norm_final': 1.0 + nrm(ks[23], (D_MODEL,), 0.02),
    }


def reference(x_prompt, x_sample, cache_a_k, cache_a_v, cache_b_k, cache_b_v, cache_mem_k, cache_mem_v,
              mem_prompt, norm_in, w_in, rel_bias, lambda_q1, lambda_k1, lambda_q2, lambda_k2, subln,
              norm_mem, w_mem_kv, w_branch_a, w_branch_b, w_branch_m, w_out, norm_final):
    hp, hs = x_prompt, x_sample
    s = x_prompt.shape[1]
    t = x_sample.shape[1]
    past = cache_b_k.shape[2]
    pos_p = jnp.arange(s)
    pos_s = past + jnp.arange(t)
    keep = min(A_PAST, s)
    new = [[] for _ in range(10)]
    for l in range(DEPTH):
        lam_init = lambda_init(l)
        lam = diff_lambda(lambda_q1[l], lambda_k1[l], lambda_q2[l], lambda_k2[l], lam_init)
        qa, ka, va, qb, kb, vb, qm, za, zb, zm, g = project_in(hp, pos_p, norm_in[l], w_in[l])
        o_a = chunk_attn_prompt(qa, ka, va, rel_bias[l])
        o_b = diff_attn_prompt(qb, kb, vb, lam, subln[l], lam_init)
        mk, mv = memory_kv(mem_prompt, norm_mem[l], w_mem_kv[l])
        o_m = mem_attn(qm, mk, mv)
        hp = hp + merge_branches(o_a, za, o_b, zb, o_m, zm, g, w_branch_a[l], w_branch_b[l], w_branch_m[l], w_out[l])
        new[0].append(ka[:, s - keep:])
        new[1].append(va[:, s - keep:])
        new[2].append(kb)
        new[3].append(vb)
        new[4].append(mk)
        new[5].append(mv)
        qa, ka, va, qb, kb, vb, qm, za, zb, zm, g = project_in(hs, pos_s, norm_in[l], w_in[l])
        o_a = chunk_attn_sample(qa, ka, va, cache_a_k[l], cache_a_v[l], rel_bias[l])
        o_b = diff_attn_sample(qb, kb, vb, cache_b_k[l], cache_b_v[l], lam, subln[l], lam_init)
        o_m = mem_attn(qm, cache_mem_k[l], cache_mem_v[l])
        hs = hs + merge_branches(o_a, za, o_b, zb, o_m, zm, g, w_branch_a[l], w_branch_b[l], w_branch_m[l], w_out[l])
        new[6].append(ka)
        new[7].append(va)
        new[8].append(kb)
        new[9].append(vb)
    y_prompt = rmsnorm(hp, norm_final)
    y_sample = rmsnorm(hs, norm_final)
    return (y_prompt, y_sample, jnp.stack(new[0]), jnp.stack(new[1]), jnp.stack(new[2]), jnp.stack(new[3]),
            jnp.stack(new[4]), jnp.stack(new[5]), jnp.stack(new[6]), jnp.stack(new[7]), jnp.stack(new[8]),
            jnp.stack(new[9]))
```

```cpp
#include <hip/hip_runtime.h>
#include <hip/hip_cooperative_groups.h>
#include <cstdint>
#include <cstdio>
namespace cg = cooperative_groups;

#define LAS __attribute__((address_space(3)))
#define GAS __attribute__((address_space(1)))
typedef unsigned short bf16_t;
typedef short bf16x8 __attribute__((ext_vector_type(8)));
typedef short s16x4 __attribute__((ext_vector_type(4)));
typedef float f32x2 __attribute__((ext_vector_type(2)));
typedef float f32x4 __attribute__((ext_vector_type(4)));
typedef float f32x16 __attribute__((ext_vector_type(16)));
typedef unsigned u32x2 __attribute__((ext_vector_type(2)));
typedef unsigned u32x4 __attribute__((ext_vector_type(4)));
typedef __bf16 bf16x2_t __attribute__((ext_vector_type(2)));

constexpr int DM = 1024;
constexpr int NBATCH = 16, SEQ = 4096, TOK = NBATCH * SEQ;
constexpr int SBATCH = 8, STEP = 16, STOK = SBATCH * STEP;
constexpr int PAST = 4096, APAST = 512;
constexpr int ROWS = TOK + 256;
constexpr int NMEM = 256, MEMROWS = NBATCH * NMEM;
constexpr int BW = 512;
constexpr int NPROJ = 5120;
constexpr float RMS_EPS = 1e-6f;
constexpr float LOG2E = 1.4426950408889634f;
constexpr float LAM_INIT = 0.2f;
constexpr int SKA_ROWS = 576, SKB_ROWS = 4160;

constexpr size_t O_Y = 0, O_YS = 67108864, O_AK = O_YS + 131072, O_AV = O_AK + 4194304, O_BK = O_AV + 4194304, O_BV = O_BK + 33554432,
                 O_MK = O_BV + 33554432, O_MV = O_MK + 2097152, O_SAK = O_MV + 2097152, O_SAV = O_SAK + 65536, O_SBK = O_SAV + 65536, O_SBV = O_SBK + 65536,
                 O_TOTAL = O_SBV + 65536;
static_assert(O_TOTAL == 147193856, "d_out size");

constexpr size_t MiB = 1u << 20;
constexpr size_t WS_CTL = 0;
constexpr size_t WS_WTIN = 1 * MiB;
constexpr size_t WS_WTBR = 19 * MiB;
constexpr size_t WS_WTOUT = 25 * MiB;
constexpr size_t WS_ROPE = 27 * MiB;
constexpr size_t WS_ROWSQ = 29 * MiB;
constexpr int SLD = 1024;
constexpr size_t WS_MKV = 34 * MiB;
constexpr size_t WS_SKVA = 42 * MiB;
constexpr size_t WS_SMKV = 51 * MiB;
constexpr size_t WS_SKVB = 55 * MiB;
constexpr size_t WS_SLOT0 = 120 * MiB, PAIR_BYTES = (size_t)ROWS * SLD * 2;
enum Slot { S_AK = 0, S_AV, S_BQ, S_BK, S_AQ, S_BV, S_MQ, S_AZ, S_BZ, S_MZ, S_N };
constexpr size_t WS_MIXED = WS_SLOT0;
constexpr size_t WS_GSTASH = WS_SLOT0 + PAIR_BYTES;
constexpr size_t WS_END = WS_SLOT0 + (S_N / 2) * PAIR_BYTES;
static_assert(WS_END <= 1024 * MiB, "d_ws map");
constexpr size_t H_BYTES = (size_t)(ROWS + MEMROWS) * DM * 2;
static_assert(H_BYTES <= (size_t)O_YS * 4, "H fits the y_prompt region");

constexpr int CW_LAM = 16;
constexpr int CW_QUEUE = 64;

constexpr int LDS_BYTES = 147456;
constexpr int NWAVES = 8, NTHREADS = 512;

__device__ __forceinline__ unsigned cvtpk(float lo, float hi) { f32x2 v = {lo, hi}; bf16x2_t b = __builtin_convertvector(v, bf16x2_t); return __builtin_bit_cast(unsigned, b); }
__device__ __forceinline__ float bf_lo(unsigned u) { return __uint_as_float(u << 16); }
__device__ __forceinline__ float bf_hi(unsigned u) { return __uint_as_float(u & 0xffff0000u); }
__device__ __forceinline__ float wave_sum(float v) {
#pragma unroll
    for (int o = 1; o < 64; o <<= 1) v += __shfl_xor(v, o);
    return v;
}
__device__ __forceinline__ float fast_sigmoid(float x) { return __builtin_amdgcn_rcpf(1.0f + __builtin_amdgcn_exp2f(-x * LOG2E)); }
#define LDS_WAIT() asm volatile("s_waitcnt lgkmcnt(0)" ::: "memory")
#define VM_WAIT() asm volatile("s_waitcnt vmcnt(0)" ::: "memory")
namespace pg8 {
constexpr int BM = 256, BK = 64, HALF = 128, HTB = HALF * BK * 2  , STAGE_BYTES = 8 * HTB;
__host__ __device__ __forceinline__ int lds_byte(int r, int c) { const int st = (r >> 4) * 2 + (c >> 5), rr = r & 15, cc = c & 31, ob = rr * 64 + cc * 2; return st * 1024 + (ob ^ (((ob >> 9) & 1) << 5)); }
__host__ __device__ __forceinline__ void stage_rc(int b, int& R, int& C) { const int st = b / 1024, sb = b % 1024, swz = sb ^ (((sb >> 9) & 1) << 5); R = (st >> 1) * 16 + swz / 64; C = (st & 1) * 32 + (swz % 64) / 2; }
__host__ __device__ __forceinline__ int perm32(int rho) { const int n = rho >> 4, i = rho & 15; return 8 * (i >> 2) + 4 * n + (i & 3); }

constexpr unsigned LD = 2048;
struct GUnit { const char* a; const char* b; int nt; int kind; int pm, pn; };

template <class Epi, class Sched>
__device__ __forceinline__ void gemm_phase(LAS unsigned char* lds, const Sched& S, const Epi& E) {
    const int tid = threadIdx.x, wid = __builtin_amdgcn_readfirstlane(tid >> 6), lane = tid & 63, wr = wid >> 2, wc = wid & 3, fr = lane & 15, fq = lane >> 4;
    unsigned RA[2], RB[2], C2[2];
#pragma unroll
    for (int i = 0; i < 2; ++i) { int R, C; stage_rc(tid * 16 + i * 8192, R, C); RA[i] = (unsigned)R; RB[i] = (unsigned)((R & ~31) + perm32(R & 31)); C2[i] = (unsigned)(C * 2); }
    const size_t kstep = (size_t)(BK * 2);
    const unsigned ldsw = (unsigned)wid * 1024u;
    const int aoff = lds_byte(wr * 64 + fr, fq * 8), boff = lds_byte(wc * 32 + fr, fq * 8);
#define PG8_SA(b, h) (((b) * 2 + (h)) * HTB)
#define PG8_SB(b, h) ((4 + (b) * 2 + (h)) * HTB)
#define PG8_STAGE(bufoff, gbase, RV) do { _Pragma("unroll") for (int _i = 0; _i < 2; ++_i) \
        __builtin_amdgcn_global_load_lds((const unsigned*)((const char*)(gbase) + (size_t)(RV[_i] * LD + C2[_i])), (LAS unsigned*)(lds + (bufoff) + ldsw + _i * 8192), 16, 0, 0); } while (0)
#define PG8_LDA(dst, b, h) do { _Pragma("unroll") for (int m = 0; m < 4; ++m) _Pragma("unroll") for (int k = 0; k < 2; ++k) dst[m][k] = *(const LAS bf16x8*)(lds + PG8_SA(b, h) + aoff + m * 2048 + k * 1024); } while (0)
#define PG8_LDB(dst, b, h) do { _Pragma("unroll") for (int n = 0; n < 2; ++n) _Pragma("unroll") for (int k = 0; k < 2; ++k) dst[n][k] = *(const LAS bf16x8*)(lds + PG8_SB(b, h) + boff + n * 2048 + k * 1024); } while (0)
#define PG8_MMA(ai, bj, At, Bt) do { __builtin_amdgcn_s_setprio(1); _Pragma("unroll") for (int m = 0; m < 4; ++m) _Pragma("unroll") for (int n = 0; n < 2; ++n) _Pragma("unroll") for (int k = 0; k < 2; ++k) \
        acc[ai][bj][m][n] = __builtin_amdgcn_mfma_f32_16x16x32_bf16(Bt[n][k], At[m][k], acc[ai][bj][m][n], 0, 0, 0); __builtin_amdgcn_s_setprio(0); } while (0)
#define PG8_WAIT_V(n) asm volatile("s_waitcnt vmcnt(" #n ")" ::: "memory")
#define PG8_WAIT_L(n) asm volatile("s_waitcnt lgkmcnt(" #n ")" ::: "memory")
#define PG8_BAR __builtin_amdgcn_s_barrier()
#define PG8_SCHED __builtin_amdgcn_sched_barrier(0)
    GUnit cur, nxt; int ui = 0;
    if (!S.next(0, cur)) return;
    f32x4 acc[2][2][4][2];
#pragma unroll
    for (int a = 0; a < 2; ++a)
#pragma unroll
        for (int b = 0; b < 2; ++b)
#pragma unroll
            for (int m = 0; m < 4; ++m)
#pragma unroll
                for (int n = 0; n < 2; ++n) acc[a][b][m][n] = (f32x4){0.f, 0.f, 0.f, 0.f};
    bf16x8 At[4][2], B0[2][2], B1[2][2];
    const char* cA = cur.a; const char* cB = cur.b;
    {
        constexpr size_t hA = (size_t)HALF * LD, hB = (size_t)HALF * LD;
        PG8_STAGE(PG8_SB(0, 0), cB, RB); PG8_STAGE(PG8_SB(0, 1), cB + hB, RB); PG8_STAGE(PG8_SA(0, 0), cA, RA); PG8_STAGE(PG8_SA(0, 1), cA + hA, RA);
        if (wr == 1) PG8_BAR;
        PG8_WAIT_V(2); PG8_BAR;
        PG8_STAGE(PG8_SB(1, 0), cB + kstep, RB); PG8_STAGE(PG8_SA(1, 0), cA + kstep, RA); PG8_STAGE(PG8_SB(1, 1), cB + hB + kstep, RB);
        PG8_WAIT_V(6); PG8_BAR;
    }
    for (;;) {
        const bool has_next = S.next(ui + 1, nxt);
        const char* nA = has_next ? nxt.a : cA; const char* nB = has_next ? nxt.b : cB;
        const int nt = cur.nt;
        constexpr size_t hA = (size_t)HALF * LD, hB = (size_t)HALF * LD, hA2 = hA, hB2 = hB;
        for (int t = 0; t < nt; t += 2) {
            const bool last = (t == nt - 2);
            const char* a1 = cA + (size_t)(t + 1) * kstep;
            const char* a2 = last ? nA : cA + (size_t)(t + 2) * kstep; const char* b2 = last ? nB : cB + (size_t)(t + 2) * kstep;
            const char* a3 = a2 + kstep; const char* b3 = b2 + kstep;
            PG8_LDB(B0, 0, 0); PG8_LDB(B1, 0, 1); PG8_SCHED; PG8_LDA(At, 0, 0); PG8_STAGE(PG8_SA(1, 1), a1 + hA, RA);
            PG8_WAIT_V(8); PG8_WAIT_L(0); PG8_BAR; PG8_MMA(0, 0, At, B0); PG8_MMA(0, 1, At, B1); PG8_BAR; PG8_SCHED;
            PG8_LDA(At, 0, 1); PG8_STAGE(PG8_SB(0, 0), b2, RB); PG8_STAGE(PG8_SB(0, 1), b2 + hB2, RB); PG8_STAGE(PG8_SA(0, 0), a2, RA);
            PG8_WAIT_V(8); PG8_WAIT_L(0); PG8_BAR; PG8_MMA(1, 0, At, B0); PG8_MMA(1, 1, At, B1); PG8_BAR; PG8_SCHED;
            PG8_LDB(B0, 1, 0); PG8_LDB(B1, 1, 1); PG8_SCHED; PG8_LDA(At, 1, 0); PG8_STAGE(PG8_SA(0, 1), a2 + hA2, RA);
            PG8_WAIT_V(8); PG8_WAIT_L(0); PG8_BAR; PG8_MMA(0, 0, At, B0); PG8_MMA(0, 1, At, B1); PG8_BAR; PG8_SCHED;
            PG8_LDA(At, 1, 1); PG8_STAGE(PG8_SB(1, 0), b3, RB); PG8_STAGE(PG8_SB(1, 1), b3 + hB2, RB); PG8_STAGE(PG8_SA(1, 0), a3, RA);
            PG8_WAIT_V(8); PG8_WAIT_L(0); PG8_BAR; PG8_MMA(1, 0, At, B0); PG8_MMA(1, 1, At, B1); PG8_BAR; PG8_SCHED;
        }
        if (wr == 0) PG8_BAR;
        E(acc, cur, wr, wc, fr, fq);
        if (!has_next) break;
        cur = nxt; cA = nA; cB = nB; ++ui;
        if (wr == 1) PG8_BAR;
    }
    PG8_WAIT_V(0);
    PG8_BAR;
#undef PG8_SA
#undef PG8_SB
#undef PG8_STAGE
#undef PG8_LDA
#undef PG8_LDB
#undef PG8_MMA
#undef PG8_WAIT_V
#undef PG8_WAIT_L
#undef PG8_BAR
#undef PG8_SCHED
}
__device__ __forceinline__ void tile_order(int L, int nM, int nN, int& pm, int& pn) {
    constexpr int NXCD = 8, WGM = 8;
    const int nwg = nM * nN; int wgid = L; { const int q = nwg / NXCD, r = nwg % NXCD, xcd = wgid % NXCD, off = wgid / NXCD; wgid = (xcd < r ? xcd * (q + 1) : r * (q + 1) + (xcd - r) * q) + off; }
    const int nig = WGM * nN, gid = wgid / nig, fm = gid * WGM, gsz = (nM - fm) < WGM ? (nM - fm) : WGM;
    pm = fm + ((wgid % nig) % gsz); pn = (wgid % nig) / gsz;
}
}
struct Args {
    const float* in[24];
    float* out; unsigned char* ws;
    int ph_lo, ph_hi;
};
struct Frame {
    LAS unsigned char* lds;
    int tid, lane, wave, G, bid;
    const float* const* in;
    float* out; unsigned char* ws;
};
enum In { I_XP = 0, I_XS, I_CAK, I_CAV, I_CBK, I_CBV, I_CMK, I_CMV, I_MEM, I_NORM_IN, I_W_IN, I_RELB, I_LQ1, I_LK1, I_LQ2, I_LK2, I_SUBLN, I_NORM_MEM, I_W_MEMKV, I_WBA, I_WBB, I_WBM, I_WOUT, I_NORM_F };

__device__ __forceinline__ bf16_t* slot_ptr(unsigned char* ws, int s) { return (bf16_t*)(ws + WS_SLOT0 + (size_t)(s >> 1) * PAIR_BYTES) + (s & 1) * BW; }

__device__ __forceinline__ void p0_transpose_item(const float* W, int N, bf16_t* WT, int k0, int n0, int dn0, LAS float* scr, int lane) {
#pragma unroll 8
    for (int i = 0; i < 32; ++i) { const int kk = 2 * i + (lane >> 5); scr[kk * 33 + (lane & 31)] = W[(size_t)(k0 + kk) * N + n0 + (lane & 31)]; }
    LDS_WAIT(); asm volatile("" ::: "memory");
    const int c = lane & 7;
#pragma unroll
    for (int j = 0; j < 4; ++j) { const int n = (lane >> 3) + 8 * j; const LAS float* s = scr + (8 * c) * 33 + n;
        u32x4 o; o.x = cvtpk(s[0 * 33], s[1 * 33]); o.y = cvtpk(s[2 * 33], s[3 * 33]); o.z = cvtpk(s[4 * 33], s[5 * 33]); o.w = cvtpk(s[6 * 33], s[7 * 33]);
        *(u32x4*)(WT + (size_t)(dn0 + n) * SLD + k0 + 8 * c) = o; }
    LDS_WAIT(); asm volatile("" ::: "memory");
}
__device__ __forceinline__ int win_dest(int n0) {
    const int tile = n0 >> 8; if (tile < 8 || tile > 11) return n0;
    const int tb = (n0 & 255) >> 5;
    return tile * 256 + 32 * (4 * (tb & 1) + (tb >> 1));
}
__device__ __forceinline__ void rms_row_to_bf16(const float* xrow, const float* g, bf16_t* orow, int lane) {
    const f32x4* xr = (const f32x4*)xrow + lane; const f32x4* gr = (const f32x4*)g + lane;
    f32x4 v[4]; float s = 0.f;
#pragma unroll
    for (int j = 0; j < 4; ++j) { v[j] = xr[64 * j]; s += (v[j].x * v[j].x + v[j].y * v[j].y) + (v[j].z * v[j].z + v[j].w * v[j].w); }
    const float r = 1.0f / sqrtf(wave_sum(s) * (1.f / DM) + RMS_EPS);
    u32x2* o8 = (u32x2*)orow + lane;
#pragma unroll
    for (int j = 0; j < 4; ++j) { const f32x4 gg = gr[64 * j]; u32x2 w; w.x = cvtpk(v[j].x * r * gg.x, v[j].y * r * gg.y); w.y = cvtpk(v[j].z * r * gg.z, v[j].w * r * gg.w); o8[64 * j] = w; }
}
__device__ __forceinline__ void cvt_cache(const float* src, bf16_t* dst, int nb, int rows, int drows, int gtid, int gthreads) {
    const int per_b = rows * 64, total = nb * per_b;
    for (int it = gtid; it < total; it += gthreads) {
        const int b = it / per_b, r = it - b * per_b;
        const f32x4* s = (const f32x4*)(src + (size_t)it * 8); const f32x4 a = s[0], c = s[1];
        u32x4 o; o.x = cvtpk(a.x, a.y); o.y = cvtpk(a.z, a.w); o.z = cvtpk(c.x, c.y); o.w = cvtpk(c.z, c.w);
        *(u32x4*)(dst + ((size_t)b * drows + (r >> 6)) * SLD + (r & 63) * 8) = o;
    }
}
__device__ __forceinline__ void zero_rows(bf16_t* dst, int nb, int r0, int r1, int drows, int gtid, int gthreads) {
    const int per_b = (r1 - r0) * 64, total = nb * per_b;
    for (int it = gtid; it < total; it += gthreads) { const int b = it / per_b, r = it - b * per_b; *(u32x4*)(dst + ((size_t)b * drows + r0 + (r >> 6)) * SLD + (r & 63) * 8) = (u32x4){0u, 0u, 0u, 0u}; }
}
__device__ __forceinline__ void p0_prologue(Frame& F) {
    LAS float* scr = (LAS float*)(F.lds + F.wave * 16384);
    const int gw = F.bid * NWAVES + F.wave, NGW = F.G * NWAVES, lane = F.lane;
    const int gtid = F.bid * NTHREADS + F.tid, NGT = F.G * NTHREADS;
    unsigned char* ws = F.ws;
    bf16_t* WTIN = (bf16_t*)(ws + WS_WTIN); bf16_t* WTBR = (bf16_t*)(ws + WS_WTBR); bf16_t* WTOUT = (bf16_t*)(ws + WS_WTOUT);
    constexpr int I_IN = (DM / 64) * (8192 / 32), I_MEMKV = (DM / 64) * (1024 / 32), I_BR = (BW / 64) * (DM / 32), I_OUT = (DM / 64) * (DM / 32);
    constexpr int NITEMS = I_IN + I_MEMKV + 3 * I_BR + I_OUT;
    for (int it = gw; it < NITEMS; it += NGW) {
        int r = it;
        if (r < I_IN) { const int nb = r % 256, kb = r / 256; p0_transpose_item(F.in[I_W_IN], 8192, WTIN, 64 * kb, 32 * nb, win_dest(32 * nb), scr, lane); continue; } r -= I_IN;
        if (r < I_MEMKV) { const int nb = r % 32, kb = r / 32; p0_transpose_item(F.in[I_W_MEMKV], 1024, WTIN + (size_t)8192 * DM, 64 * kb, 32 * nb, 32 * nb, scr, lane); continue; } r -= I_MEMKV;
        if (r < 3 * I_BR) { const int br = r / I_BR, q = r % I_BR, nb = q % 32, kb = q / 32; p0_transpose_item(F.in[I_WBA + br], DM, WTBR + (size_t)br * DM * SLD, 64 * kb, 32 * nb, 32 * nb, scr, lane); continue; } r -= 3 * I_BR;
        { const int nb = r % 32, kb = r / 32; p0_transpose_item(F.in[I_WOUT], DM, WTOUT, 64 * kb, 32 * nb, 32 * nb, scr, lane); }
    }
    bf16_t* H = (bf16_t*)F.out;
    for (int m = gw; m < ROWS + MEMROWS; m += NGW) {
        bf16_t* orow = H + (size_t)m * DM;
        if (m < TOK) rms_row_to_bf16(F.in[I_XP] + (size_t)m * DM, F.in[I_NORM_IN], orow, lane);
        else if (m < TOK + STOK) rms_row_to_bf16(F.in[I_XS] + (size_t)(m - TOK) * DM, F.in[I_NORM_IN], orow, lane);
        else if (m < ROWS) { u32x2* o8 = (u32x2*)orow + lane; for (int j = 0; j < 4; ++j) o8[64 * j] = (u32x2){0u, 0u}; }
        else rms_row_to_bf16(F.in[I_MEM] + (size_t)(m - ROWS) * DM, F.in[I_NORM_MEM], orow, lane);
    }
    cvt_cache(F.in[I_CAK], (bf16_t*)(ws + WS_SKVA), SBATCH, APAST, SKA_ROWS, gtid, NGT);
    cvt_cache(F.in[I_CAV], (bf16_t*)(ws + WS_SKVA) + BW, SBATCH, APAST, SKA_ROWS, gtid, NGT);
    cvt_cache(F.in[I_CBK], (bf16_t*)(ws + WS_SKVB), SBATCH, PAST, SKB_ROWS, gtid, NGT);
    cvt_cache(F.in[I_CBV], (bf16_t*)(ws + WS_SKVB) + BW, SBATCH, PAST, SKB_ROWS, gtid, NGT);
    cvt_cache(F.in[I_CMK], (bf16_t*)(ws + WS_SMKV), SBATCH, NMEM, NMEM, gtid, NGT);
    cvt_cache(F.in[I_CMV], (bf16_t*)(ws + WS_SMKV) + BW, SBATCH, NMEM, NMEM, gtid, NGT);
    zero_rows((bf16_t*)(ws + WS_SKVA), SBATCH, APAST + STEP, SKA_ROWS, SKA_ROWS, gtid, NGT);
    zero_rows((bf16_t*)(ws + WS_SKVA) + BW, SBATCH, APAST + STEP, SKA_ROWS, SKA_ROWS, gtid, NGT);
    zero_rows((bf16_t*)(ws + WS_SKVB), SBATCH, PAST + STEP, SKB_ROWS, SKB_ROWS, gtid, NGT);
    zero_rows((bf16_t*)(ws + WS_SKVB) + BW, SBATCH, PAST + STEP, SKB_ROWS, SKB_ROWS, gtid, NGT);
    float* rope = (float*)(ws + WS_ROPE);
    for (int it = gtid; it < (PAST + STEP) * 32; it += NGT) {
        const int pos = it >> 5, i = it & 31;
        const float inv = 1.0f / powf(10000.0f, (float)(2 * i) / 64.0f);
        const float ang = (float)pos * inv;
        rope[pos * 64 + i] = cosf(ang); rope[pos * 64 + 32 + i] = sinf(ang);
    }
    if (F.bid == 0) {
        unsigned* ctl = (unsigned*)(ws + WS_CTL);
        if (F.wave == 0) {
            const float a = F.in[I_LQ1][lane] * F.in[I_LK1][lane], b = F.in[I_LQ2][lane] * F.in[I_LK2][lane];
            const float sa = wave_sum(a), sb = wave_sum(b);
            if (lane == 0) ((float*)ctl)[CW_LAM] = expf(sa) - expf(sb) + LAM_INIT;
        }
        if (F.wave == 1 && lane < 16) ctl[CW_QUEUE + 64 * lane] = 0u;
    }
}

constexpr int P1_NM = TOK / 256, P1_NN = NPROJ / 256;
constexpr int P1_MAIN = P1_NM * P1_NN, P1_SAMPLE = P1_NN, P1_MEMKV = (MEMROWS / 256) * 4, P1_UNITS = P1_MAIN + P1_SAMPLE + P1_MEMKV;
struct P1Sched {
    const char* H; const char* WT; int G, c;
    __device__ __forceinline__ bool next(int i, pg8::GUnit& u) const {
        const int L = i * G + c; if (L >= P1_UNITS) return false;
        int pm, pn, kind = 0; int brow;
        if (L < P1_MAIN) { pg8::tile_order(L, P1_NM, P1_NN, pm, pn); brow = 256 * pn; }
        else if (L < P1_MAIN + P1_SAMPLE) { pm = P1_NM; pn = L - P1_MAIN; brow = 256 * pn; }
        else { const int e = L - P1_MAIN - P1_SAMPLE; pm = (ROWS / 256) + (e >> 2); pn = e & 3; brow = 8192 + 256 * pn; kind = 1; }
        u.a = H + (size_t)pm * 256 * (DM * 2); u.b = WT + (size_t)brow * (DM * 2); u.nt = DM / 64; u.kind = kind; u.pm = pm; u.pn = pn;
        return true;
    }
};
struct P1Epi {
    unsigned char* ws; float* out; const float* rope;
    __device__ __forceinline__ void operator()(f32x4 (&acc)[2][2][4][2], const pg8::GUnit& u, int wr, int wc, int fr, int fq) const {
        const int pn = u.pn;
        if (u.kind == 1) {
            const int half = pn >> 1; bf16_t* dstb = (bf16_t*)(ws + WS_MKV) + half * BW; float* dstf = out + (half ? O_MV : O_MK);
#pragma unroll
            for (int ai = 0; ai < 2; ++ai)
#pragma unroll
                for (int m = 0; m < 4; ++m) {
                    const int mrow = (u.pm - ROWS / 256) * 256 + ai * 128 + wr * 64 + m * 16 + fr;
#pragma unroll
                    for (int bj = 0; bj < 2; ++bj) {
                        const int col = (pn & 1) * 256 + bj * 128 + wc * 32 + 8 * fq; const f32x4 v0 = acc[ai][bj][m][0], v1 = acc[ai][bj][m][1];
                        u32x4 w; w.x = cvtpk(v0[0], v0[1]); w.y = cvtpk(v0[2], v0[3]); w.z = cvtpk(v1[0], v1[1]); w.w = cvtpk(v1[2], v1[3]);
                        *(u32x4*)(dstb + (size_t)mrow * SLD + col) = w;
                        float* fo = dstf + (size_t)mrow * BW + col; *(f32x4*)fo = v0; *(f32x4*)(fo + 4) = v1;
                        acc[ai][bj][m][0] = (f32x4){0.f, 0.f, 0.f, 0.f}; acc[ai][bj][m][1] = (f32x4){0.f, 0.f, 0.f, 0.f};
                    }
                }
            return;
        }
        const int creg = pn >> 1;
        const int region = creg == 0 ? S_AQ : creg == 1 ? S_AK : creg == 2 ? S_AV : creg == 3 ? S_AZ : creg == 4 ? S_BQ : creg == 5 ? S_BK : creg == 6 ? S_BV : creg == 7 ? S_BZ : creg == 8 ? S_MQ : S_MZ;
        const bool is_rope = (region == S_BQ || region == S_BK);
        const bool is_silu = (region == S_AZ || region == S_BZ || region == S_MZ);
        const float scale = (region == S_AQ || region == S_BQ) ? 0.125f * LOG2E : (region == S_MQ ? 0.08838834764831845f * LOG2E : 1.0f);
        const int fmode = (region == S_AK || region == S_AV) ? 1 : ((region == S_BK || region == S_BV) ? 2 : 0);
        const bool sample = (u.pm == P1_NM);
        bf16_t* slot = slot_ptr(ws, region);
        float* fprompt = out + (region == S_AK ? O_AK : region == S_AV ? O_AV : region == S_BK ? O_BK : O_BV);
        float* fsample = out + (region == S_AK ? O_SAK : region == S_AV ? O_SAV : region == S_BK ? O_SBK : O_SBV);
        bf16_t* scache = (bf16_t*)(ws + ((region == S_AK || region == S_AV) ? WS_SKVA : WS_SKVB)) + ((region == S_AV || region == S_BV) ? BW : 0);
        const int crows = (fmode == 1) ? SKA_ROWS : SKB_ROWS, cpast = (fmode == 1) ? APAST : PAST;
#pragma unroll
        for (int ai = 0; ai < 2; ++ai)
#pragma unroll
            for (int m = 0; m < 4; ++m) {
                const int row = u.pm * 256 + ai * 128 + wr * 64 + m * 16 + fr;
                f32x4 v[2][2];
#pragma unroll
                for (int bj = 0; bj < 2; ++bj) { v[bj][0] = acc[ai][bj][m][0]; v[bj][1] = acc[ai][bj][m][1];
                    acc[ai][bj][m][0] = (f32x4){0.f, 0.f, 0.f, 0.f}; acc[ai][bj][m][1] = (f32x4){0.f, 0.f, 0.f, 0.f}; }
                if (is_rope) {
                    const int pos = sample ? (PAST + ((row - TOK) & 15)) : (row & (SEQ - 1));
                    const float* rp = rope + (size_t)pos * 64 + 8 * fq;
                    const f32x4 c0 = *(const f32x4*)rp, c1 = *(const f32x4*)(rp + 4), s0 = *(const f32x4*)(rp + 32), s1 = *(const f32x4*)(rp + 36);
                    const f32x4 x10 = v[0][0], x11 = v[0][1], x20 = v[1][0], x21 = v[1][1];
                    v[0][0] = x10 * c0 - x20 * s0; v[0][1] = x11 * c1 - x21 * s1;
                    v[1][0] = x10 * s0 + x20 * c0; v[1][1] = x11 * s1 + x21 * c1;
                }
#pragma unroll
                for (int bj = 0; bj < 2; ++bj) {
                    const int col = (pn & 1) * 256 + (is_rope ? (wc * 64 + bj * 32) : (bj * 128 + wc * 32)) + 8 * fq;
                    f32x4 v0 = v[bj][0], v1 = v[bj][1];
                    if (fmode) {
                        if (!sample) {
                            if (fmode == 2) { float* fo = fprompt + (size_t)row * BW + col; *(f32x4*)fo = v0; *(f32x4*)(fo + 4) = v1; }
                            else { const int s = row & (SEQ - 1); if (s >= SEQ - APAST) { float* fo = fprompt + ((size_t)(row >> 12) * APAST + (s - (SEQ - APAST))) * BW + col; *(f32x4*)fo = v0; *(f32x4*)(fo + 4) = v1; } }
                        } else if (row < TOK + STOK) {
                            const int sr = row - TOK; float* fo = fsample + (size_t)sr * BW + col; *(f32x4*)fo = v0; *(f32x4*)(fo + 4) = v1;
                        }
                    }
                    if (is_silu) {
#pragma unroll
                        for (int e = 0; e < 4; ++e) { v0[e] = v0[e] * fast_sigmoid(v0[e]); v1[e] = v1[e] * fast_sigmoid(v1[e]); }
                    }
                    v0 = v0 * scale; v1 = v1 * scale;
                    u32x4 w; w.x = cvtpk(v0[0], v0[1]); w.y = cvtpk(v0[2], v0[3]); w.z = cvtpk(v1[0], v1[1]); w.w = cvtpk(v1[2], v1[3]);
                    *(u32x4*)(slot + (size_t)row * SLD + col) = w;
                    if (fmode && sample && row < TOK + STOK) {
                        const int sr = row - TOK, sb = sr >> 4, t = sr & 15;
                        *(u32x4*)(scache + ((size_t)sb * crows + cpast + t) * SLD + col) = w;
                    }
                }
            }
    }
};
__device__ __forceinline__ void p1_phase(Frame& F) {
    P1Sched S{(const char*)F.out, (const char*)(F.ws + WS_WTIN), F.G, F.bid};
    P1Epi E{F.ws, F.out, (const float*)(F.ws + WS_ROPE)};
    pg8::gemm_phase<P1Epi, P1Sched>(F.lds, S, E);
}
#ifndef ATT_EN_MASK
#define ATT_EN_MASK 7
#endif
namespace att {
constexpr int TILE_B = 16384;
constexpr int L_K0 = 0, L_V0 = TILE_B, L_K1 = 2 * TILE_B, L_V1 = 3 * TILE_B;
constexpr int STG_LD = 132;
constexpr int L_STAGE = 0, STG_WAVE = 32 * STG_LD * 4;
constexpr int L_WSF = 8 * STG_WAVE;
constexpr int L_BIAS = L_WSF + 8 * 256;
constexpr int L_MISC = L_BIAS + 2 * 272 * 4;
static_assert(L_MISC + 64 <= LDS_BYTES, "attention LDS map");
constexpr float NEG_BIG = -1e30f;

__device__ __forceinline__ int crow(int r, int hi) { return (r & 3) + 8 * (r >> 2) + 4 * hi; }
__device__ __forceinline__ unsigned tile_off(unsigned row, unsigned ch) { return 256u * row + 16u * (ch ^ (((row & 3u) << 2) | ((row >> 2) & 3u))); }
typedef short v4i16_t __attribute__((ext_vector_type(4)));
__device__ __forceinline__ s16x4 vtr(LAS const unsigned char* p) { return __builtin_bit_cast(s16x4, __builtin_amdgcn_ds_read_tr16_b64_v4i16((LAS v4i16_t*)p)); }

struct Unit {
    const bf16_t* Q; const bf16_t* K; const bf16_t* V; bf16_t* Z;
    int t_begin, t_end;
    int nvalid;
    int kv_last;
    int qpos0;
    int head0;
};
struct Consts { const float* rel_bias; const float* subln; float lam; };

template <int MODE>
__device__ __forceinline__ void run_unit(LAS unsigned char* lds, const Unit& u, const Consts& cs) {
    constexpr int NKS = (MODE == 2) ? 8 : 4;
    constexpr int NDB = (MODE == 0) ? 2 : 4;
    constexpr float THR = 8.0f;
    int tid = threadIdx.x; asm volatile("" : "+v"(tid));
    const int lane = tid & 63, r32 = lane & 31, hi = lane >> 5;
    const int wid = __builtin_amdgcn_readfirstlane(tid >> 6);
    const int grp = (MODE == 2) ? 0 : (wid >> 2), sub = (MODE == 2) ? wid : (wid & 3);
    const int kc0 = (MODE == 2) ? 0 : 8 * grp;
    const int vc0 = (MODE == 0) ? 8 * grp : 0;
    const bool active = 32 * sub < u.nvalid;
    int wt0 = u.t_begin, wt1 = u.t_end;
    if (MODE != 2) { const int c = (u.qpos0 + 32 * sub) >> 6; wt1 = min(wt1, c + 1); if (MODE == 0) wt0 = max(wt0, c - 8); }
    if (!active) wt1 = wt0;
    LAS float* wsf = (LAS float*)(lds + L_WSF) + wid * 64;
    if (MODE == 0) { LAS float* bl = (LAS float*)(lds + L_BIAS);
        for (int i = tid; i < 2 * 257; i += NTHREADS) { const int h = i >= 257 ? 1 : 0, j = i - 257 * h; bl[h * 272 + j] = cs.rel_bias[(u.head0 + h) * 257 + j] * LOG2E; } }
    bf16x8 qr[NKS];
    { const bf16_t* qp = u.Q + (size_t)(32 * sub + r32) * SLD + ((MODE == 2) ? 0 : 64 * grp) + 8 * hi;
#pragma unroll
      for (int s = 0; s < NKS; ++s) qr[s] = *(const bf16x8*)(qp + 16 * s); }
    const int srow0 = tid >> 4, sch = tid & 15;
    const unsigned so0 = tile_off(srow0, sch), so1 = tile_off(srow0 + 32, sch);
    const bf16_t* kg = u.K + (size_t)srow0 * SLD + 8 * sch; const bf16_t* vg = u.V + (size_t)srow0 * SLD + 8 * sch;
    u32x4 kreg0, kreg1, vreg0, vreg1;
#define LOAD_TILE(t) do { const size_t o_ = (size_t)(t) * 64 * SLD; kreg0 = *(const u32x4*)(kg + o_); kreg1 = *(const u32x4*)(kg + o_ + 32 * SLD); vreg0 = *(const u32x4*)(vg + o_); vreg1 = *(const u32x4*)(vg + o_ + 32 * SLD); } while (0)
#define WRITE_TILE(kb, vb) do { *(LAS u32x4*)(lds + (kb) + so0) = kreg0; *(LAS u32x4*)(lds + (kb) + so1) = kreg1; *(LAS u32x4*)(lds + (vb) + so0) = vreg0; *(LAS u32x4*)(lds + (vb) + so1) = vreg1; } while (0)
    const unsigned xk = ((r32 & 3u) << 2) | ((r32 >> 2) & 3u);
    const unsigned kbase = 256u * r32;
    const unsigned qv = (lane & 15) >> 2, pv = lane & 3, blk = (lane >> 4) & 1;
    const unsigned vrow = 4u * hi + qv;
    f32x16 o[NDB];
#pragma unroll
    for (int c = 0; c < NDB; ++c) o[c] = f32x16{};
    float m_run = NEG_BIG, l_run = 0.f;
    const int qpos_w = u.qpos0 + 32 * sub;

    LOAD_TILE(u.t_begin);
    WRITE_TILE(L_K0, L_V0);
    __syncthreads();
    const int ntile = u.t_end - u.t_begin;
    for (int i = 0; i < ntile; ++i) {
        const int t = u.t_begin + i; const int cur = i & 1;
        const int kb = cur ? L_K1 : L_K0, vb = cur ? L_V1 : L_V0;
        if (i + 1 < ntile) LOAD_TILE(t + 1);
        if (t >= wt0 && t < wt1) {
            f32x16 p0, p1;
            if (MODE == 0) {
                const LAS float* bl = (const LAS float*)(lds + L_BIAS) + grp * 272;
                const int d0 = qpos_w - 64 * t;
                if (d0 - 63 >= 128) { const float bf = bl[256];
#pragma unroll
                    for (int r = 0; r < 16; ++r) { p0[r] = bf; p1[r] = bf; } }
                else {
#pragma unroll
                    for (int r = 0; r < 16; ++r) { const int dd = d0 + r32 - crow(r, hi);
                        p0[r] = bl[min(max(dd, -128), 128) + 128]; p1[r] = bl[min(max(dd - 32, -128), 128) + 128]; } }
            } else { p0 = f32x16{}; p1 = f32x16{}; }
#pragma unroll
            for (int s = 0; s < NKS; ++s) {
                const unsigned co = 16u * ((unsigned)(kc0 + 2 * s + hi) ^ xk);
                const bf16x8 k0 = *(const LAS bf16x8*)(lds + kb + kbase + co), k1 = *(const LAS bf16x8*)(lds + kb + 8192 + kbase + co);
                p0 = __builtin_amdgcn_mfma_f32_32x32x16_bf16(k0, qr[s], p0, 0, 0, 0);
                p1 = __builtin_amdgcn_mfma_f32_32x32x16_bf16(k1, qr[s], p1, 0, 0, 0);
            }
            if (t == u.t_end - 1 && u.kv_last < 64) {
#pragma unroll
                for (int r = 0; r < 16; ++r) { if (crow(r, hi) >= u.kv_last) p0[r] = NEG_BIG; if (32 + crow(r, hi) >= u.kv_last) p1[r] = NEG_BIG; }
            }
            float mx = fmaxf(p0[0], p1[0]);
#pragma unroll
            for (int r = 1; r < 16; ++r) mx = fmaxf(mx, fmaxf(p0[r], p1[r]));
            mx = fmaxf(mx, __shfl_xor(mx, 32));
            if (__any(mx > m_run + THR)) {
                const float mn = fmaxf(m_run, mx), f = __builtin_amdgcn_exp2f(m_run - mn);
                l_run *= f; m_run = mn;
                if (hi == 0) wsf[r32] = f;
                LDS_WAIT();
#pragma unroll
                for (int r = 0; r < 16; ++r) { const float fr_ = wsf[crow(r, hi)];
#pragma unroll
                    for (int c = 0; c < NDB; ++c) o[c][r] *= fr_; }
            }
            float ls = 0.f;
#pragma unroll
            for (int r = 0; r < 16; ++r) { p0[r] = __builtin_amdgcn_exp2f(p0[r] - m_run); p1[r] = __builtin_amdgcn_exp2f(p1[r] - m_run); ls += p0[r] + p1[r]; }
            l_run += ls;
            bf16x8 pa[4];
#pragma unroll
            for (int ks = 0; ks < 4; ++ks) { const int b8 = 8 * (ks & 1); u32x4 w;
                if (ks < 2) { w.x = cvtpk(p0[b8], p0[b8 + 1]); w.y = cvtpk(p0[b8 + 2], p0[b8 + 3]); w.z = cvtpk(p0[b8 + 4], p0[b8 + 5]); w.w = cvtpk(p0[b8 + 6], p0[b8 + 7]); }
                else { w.x = cvtpk(p1[b8], p1[b8 + 1]); w.y = cvtpk(p1[b8 + 2], p1[b8 + 3]); w.z = cvtpk(p1[b8 + 4], p1[b8 + 5]); w.w = cvtpk(p1[b8 + 6], p1[b8 + 7]); }
                pa[ks] = __builtin_bit_cast(bf16x8, w); }
#pragma unroll
            for (int c = 0; c < NDB; ++c) {
#pragma unroll
                for (int ks = 0; ks < 4; ++ks) {
                    s16x4 lo, hh;
                    { const unsigned row = 16u * ks + vrow, ch = (unsigned)(vc0 + 4 * c) + 2u * blk + (pv >> 1); lo = vtr(lds + vb + tile_off(row, ch) + 8u * (pv & 1)); }
                    { const unsigned row = 16u * ks + 8u + vrow, ch = (unsigned)(vc0 + 4 * c) + 2u * blk + (pv >> 1); hh = vtr(lds + vb + tile_off(row, ch) + 8u * (pv & 1)); }
                    const bf16x8 vf = (bf16x8){lo[0], lo[1], lo[2], lo[3], hh[0], hh[1], hh[2], hh[3]};
                    o[c] = __builtin_amdgcn_mfma_f32_32x32x16_bf16(pa[ks], vf, o[c], 0, 0, 0);
                }
            }
        }
        if (i + 1 < ntile) { if (cur) WRITE_TILE(L_K0, L_V0); else WRITE_TILE(L_K1, L_V1); }
        __syncthreads();
    }
#undef LOAD_TILE
#undef WRITE_TILE
    { float lt = l_run + __shfl_xor(l_run, 32); const float inv = active ? __builtin_amdgcn_rcpf(lt) : 0.f;
      if (hi == 0) wsf[32 + r32] = inv; LDS_WAIT(); }
    float rli[16];
#pragma unroll
    for (int r = 0; r < 16; ++r) rli[r] = wsf[32 + crow(r, hi)];
    if (MODE != 1) {
        LAS float* stg = (LAS float*)(lds + L_STAGE + wid * STG_WAVE);
#pragma unroll
        for (int c = 0; c < NDB; ++c)
#pragma unroll
            for (int r = 0; r < 16; ++r) stg[crow(r, hi) * STG_LD + 32 * c + r32] = o[c][r] * rli[r];
        LDS_WAIT(); asm volatile("" ::: "memory");
        constexpr int NC = 32 * NDB, HC = NC / 2;
        const int row = lane >> 1, half = lane & 1;
        if (32 * sub + row < u.nvalid) {
            bf16_t* zp = u.Z + (size_t)(32 * sub + row) * SLD + ((MODE == 0) ? 64 * grp : 0) + half * HC;
            const LAS float* sp = stg + row * STG_LD + half * HC;
#pragma unroll
            for (int j = 0; j < HC / 8; ++j) {
                const f32x4 a = *(const LAS f32x4*)(sp + 8 * j), b = *(const LAS f32x4*)(sp + 8 * j + 4);
                const u32x4 z = *(const u32x4*)(zp + 8 * j);
                u32x4 w; w.x = cvtpk(a[0] * bf_lo(z.x), a[1] * bf_hi(z.x)); w.y = cvtpk(a[2] * bf_lo(z.y), a[3] * bf_hi(z.y));
                w.z = cvtpk(b[0] * bf_lo(z.z), b[1] * bf_hi(z.z)); w.w = cvtpk(b[2] * bf_lo(z.w), b[3] * bf_hi(z.w));
                if (!((ATT_EN_MASK >> MODE) & 1)) w = (u32x4){0u, 0u, 0u, 0u};
                *(u32x4*)(zp + 8 * j) = w;
            }
        }
        LDS_WAIT();
        __syncthreads();
    } else {
        LAS float* stg = (LAS float*)(lds + L_STAGE + sub * STG_WAVE);
        if (grp == 1) {
#pragma unroll
            for (int c = 0; c < NDB; ++c)
#pragma unroll
                for (int r = 0; r < 16; ++r) stg[crow(r, hi) * STG_LD + 32 * c + r32] = o[c][r] * rli[r];
        }
        LDS_WAIT(); __syncthreads();
        if (grp == 0) {
            const float lam = cs.lam;
#pragma unroll
            for (int c = 0; c < NDB; ++c)
#pragma unroll
                for (int r = 0; r < 16; ++r) { LAS float* p = stg + crow(r, hi) * STG_LD + 32 * c + r32; *p = o[c][r] * rli[r] - lam * (*p); }
        }
        LDS_WAIT(); __syncthreads();
        {
            const int urow = 16 * wid + (lane >> 2), quarter = lane & 3;
            const LAS float* sp = (const LAS float*)(lds + L_STAGE + (urow >> 5) * STG_WAVE) + (urow & 31) * STG_LD + 32 * quarter;
            f32x4 vv[8]; float ss = 0.f;
#pragma unroll
            for (int j = 0; j < 8; ++j) { vv[j] = *(const LAS f32x4*)(sp + 4 * j); ss += (vv[j][0] * vv[j][0] + vv[j][1] * vv[j][1]) + (vv[j][2] * vv[j][2] + vv[j][3] * vv[j][3]); }
            ss += __shfl_xor(ss, 1); ss += __shfl_xor(ss, 2);
            const float rn = (1.0f - LAM_INIT) / sqrtf(ss * (1.0f / 128.0f) + RMS_EPS);
            if (urow < u.nvalid) {
                bf16_t* zp = u.Z + (size_t)urow * SLD + 32 * quarter; const float* gp = cs.subln + 32 * quarter;
#pragma unroll
                for (int j = 0; j < 4; ++j) {
                    const f32x4 a = vv[2 * j], b = vv[2 * j + 1]; const f32x4 g0 = *(const f32x4*)(gp + 8 * j), g1 = *(const f32x4*)(gp + 8 * j + 4);
                    const u32x4 z = *(const u32x4*)(zp + 8 * j);
                    u32x4 w; w.x = cvtpk(a[0] * rn * g0[0] * bf_lo(z.x), a[1] * rn * g0[1] * bf_hi(z.x)); w.y = cvtpk(a[2] * rn * g0[2] * bf_lo(z.y), a[3] * rn * g0[3] * bf_hi(z.y));
                    w.z = cvtpk(b[0] * rn * g1[0] * bf_lo(z.z), b[1] * rn * g1[1] * bf_hi(z.z)); w.w = cvtpk(b[2] * rn * g1[2] * bf_lo(z.w), b[3] * rn * g1[3] * bf_hi(z.w));
                    if (!((ATT_EN_MASK >> 1) & 1)) w = (u32x4){0u, 0u, 0u, 0u};
                    *(u32x4*)(zp + 8 * j) = w;
                }
            }
        }
        LDS_WAIT();
        __syncthreads();
    }
}

constexpr int Q_SB = 4, Q_B = 256, Q_A = 256, Q_M = 128, Q_SA = 4, Q_SM = 4;
constexpr int Q_LEN = Q_SB + Q_B + Q_A + Q_M + Q_SA + Q_SM;
__device__ __forceinline__ int decode_unit(unsigned char* ws, int q, int idx, Unit& u) {
    auto S = [&](int s) { return slot_ptr(ws, s); };
    u.kv_last = 64; u.head0 = 0;
    if (idx < Q_SB) { const int sp = idx * 8 + q, b = sp >> 2, h = sp & 3; const size_t qo = (size_t)(TOK + STEP * b) * SLD + 128 * h, ko = (size_t)b * SKB_ROWS * SLD + 128 * h;
        u.Q = S(S_BQ) + qo; u.Z = S(S_BZ) + qo; u.K = (const bf16_t*)(ws + WS_SKVB) + ko; u.V = (const bf16_t*)(ws + WS_SKVB) + BW + ko;
        u.t_begin = 0; u.t_end = SKB_ROWS / 64; u.nvalid = STEP; u.kv_last = STEP; u.qpos0 = PAST; return 1; }
    idx -= Q_SB;
    if (idx < Q_B) { const int pair = (idx >> 5) * 8 + q, qt = 31 - (idx & 31), b = pair >> 2, h = pair & 3; const size_t ko = (size_t)b * SEQ * SLD + 128 * h, qo = ko + (size_t)(128 * qt) * SLD;
        u.Q = S(S_BQ) + qo; u.Z = S(S_BZ) + qo; u.K = S(S_BK) + ko; u.V = S(S_BV) + ko; u.t_begin = 0; u.t_end = 2 * qt + 2; u.nvalid = 128; u.qpos0 = 128 * qt; return 1; }
    idx -= Q_B;
    if (idx < Q_A) { const int pair = (idx >> 5) * 8 + q, cp = idx & 31, b = pair >> 2, hp = pair & 3; const size_t ko = (size_t)b * SEQ * SLD + 128 * hp, qo = ko + (size_t)(128 * cp) * SLD;
        u.Q = S(S_AQ) + qo; u.Z = S(S_AZ) + qo; u.K = S(S_AK) + ko; u.V = S(S_AV) + ko; u.t_begin = max(0, 2 * cp - 8); u.t_end = 2 * cp + 2; u.nvalid = 128; u.qpos0 = 128 * cp; u.head0 = 2 * hp; return 0; }
    idx -= Q_A;
    if (idx < Q_M) { const int pair = (idx >> 4) * 8 + q, qt = idx & 15, b = pair >> 2, h = pair & 3; const size_t qo = (size_t)(b * SEQ + 256 * qt) * SLD + 128 * h, ko = (size_t)b * NMEM * SLD + 128 * h;
        u.Q = S(S_MQ) + qo; u.Z = S(S_MZ) + qo; u.K = (const bf16_t*)(ws + WS_MKV) + ko; u.V = (const bf16_t*)(ws + WS_MKV) + BW + ko; u.t_begin = 0; u.t_end = 4; u.nvalid = 256; u.qpos0 = 0; return 2; }
    idx -= Q_M;
    if (idx < Q_SA) { const int sp = idx * 8 + q, b = sp >> 2, hp = sp & 3; const size_t qo = (size_t)(TOK + STEP * b) * SLD + 128 * hp, ko = (size_t)b * SKA_ROWS * SLD + 128 * hp;
        u.Q = S(S_AQ) + qo; u.Z = S(S_AZ) + qo; u.K = (const bf16_t*)(ws + WS_SKVA) + ko; u.V = (const bf16_t*)(ws + WS_SKVA) + BW + ko; u.t_begin = 0; u.t_end = SKA_ROWS / 64; u.nvalid = STEP; u.kv_last = STEP; u.qpos0 = APAST; u.head0 = 2 * hp; return 0; }
    idx -= Q_SA;
    { const int sp = idx * 8 + q, b = sp >> 2, h = sp & 3; const size_t qo = (size_t)(TOK + STEP * b) * SLD + 128 * h, ko = (size_t)b * NMEM * SLD + 128 * h;
        u.Q = S(S_MQ) + qo; u.Z = S(S_MZ) + qo; u.K = (const bf16_t*)(ws + WS_SMKV) + ko; u.V = (const bf16_t*)(ws + WS_SMKV) + BW + ko; u.t_begin = 0; u.t_end = 4; u.nvalid = STEP; u.qpos0 = 0; return 2; }
}
__device__ __forceinline__ unsigned xcc_id() { return (unsigned)__builtin_amdgcn_s_getreg((3 << 11) | 20) & 0x7u; }
}

__device__ __forceinline__ void p2_phase(Frame& F) {
    using namespace att;
    unsigned* ctl = (unsigned*)(F.ws + WS_CTL);
    volatile LAS int* misc = (volatile LAS int*)(F.lds + L_MISC);
    Consts cs; cs.rel_bias = F.in[I_RELB]; cs.subln = F.in[I_SUBLN]; cs.lam = ((const float*)ctl)[CW_LAM];
    const int myq = (int)xcc_id();
    int qoff = 0;
#define P2_FETCH(dst) do { int r_ = -1; while (qoff < 8) { const int q_ = (myq + qoff) & 7; const unsigned idx_ = __hip_atomic_fetch_add(ctl + CW_QUEUE + 64 * q_, 1u, __ATOMIC_RELAXED, __HIP_MEMORY_SCOPE_AGENT); \
        if (idx_ < (unsigned)Q_LEN) { r_ = (q_ << 16) | (int)idx_; break; } ++qoff; } (dst) = r_; } while (0)
    if (F.tid == 0) P2_FETCH(misc[0]);
    __syncthreads();
    for (;;) {
        const int code = misc[0];
        __syncthreads();
        if (code < 0) break;
        if (F.tid == 0) P2_FETCH(misc[0]);
        Unit u; const int mode = decode_unit(F.ws, code >> 16, code & 0xffff, u);
        if (mode == 0) run_unit<0>(F.lds, u, cs); else if (mode == 1) run_unit<1>(F.lds, u, cs); else run_unit<2>(F.lds, u, cs);
        __syncthreads();
    }
}
constexpr int P3_TILES = (TOK / 256) * 4 + 4;
struct P3Sched {
    const char* H; const char* WT; const char* WTBR; unsigned char* ws; int G, c;
    __device__ __forceinline__ bool next(int i, pg8::GUnit& u) const {
        const int tu = i / 6, j = i - 6 * tu; const int L = tu * G + c; if (L >= P3_TILES) return false;
        int pm, pn; if (L < 1024) pg8::tile_order(L, TOK / 256, 4, pm, pn); else { pm = TOK / 256; pn = L - 1024; }
        u.pm = pm; u.pn = pn; u.kind = j;
        if (j < 3) { u.a = H + (size_t)pm * 256 * (DM * 2); u.b = WT + (size_t)(NPROJ + 1024 * j + 256 * pn) * (DM * 2); u.nt = DM / 64; }
        else { const int b = j - 3; const int s = (b == 0) ? S_AZ : (b == 1 ? S_BZ : S_MZ);
            u.a = (const char*)(slot_ptr(ws, s) + (size_t)pm * 256 * SLD); u.b = WTBR + ((size_t)b * DM + 256 * pn) * (SLD * 2); u.nt = BW / 64; }
        return true;
    }
};
struct P3Epi {
    unsigned char* gst; bf16_t* mixed;
    __device__ __forceinline__ void operator()(f32x4 (&acc)[2][2][4][2], const pg8::GUnit& u, int wr, int wc, int fr, int fq) const {
        const int kind = u.kind; const unsigned toff = threadIdx.x * 16u;
        const unsigned char* pn_ = gst + (size_t)(kind >= 3 ? kind - 3 : 0) * 131072 + toff;
        const unsigned char* pd_ = gst + (size_t)(kind == 3 || kind == 4 ? kind - 2 : 0) * 131072 + toff;
        unsigned char* dst = gst + (size_t)(kind < 3 ? kind : 0) * 131072 + toff;
        bf16_t* mp = mixed + (size_t)(u.pm * 256 + wr * 64 + fr) * DM + u.pn * 256 + wc * 32 + 8 * fq;
#pragma unroll
        for (int ai = 0; ai < 2; ++ai) {
#pragma unroll
            for (int m = 0; m < 4; ++m) {
#pragma unroll
                for (int bj = 0; bj < 2; ++bj) {
                    const f32x4 v0 = acc[ai][bj][m][0], v1 = acc[ai][bj][m][1];
                    f32x4 m0 = (f32x4){0.f, 0.f, 0.f, 0.f}, m1 = (f32x4){0.f, 0.f, 0.f, 0.f};
                    if (kind < 3) {
                        f32x4 s0, s1;
#pragma unroll
                        for (int e = 0; e < 4; ++e) { s0[e] = fmaxf(fast_sigmoid(v0[e]), 1e-6f); s1[e] = fmaxf(fast_sigmoid(v1[e]), 1e-6f); }
                        u32x4 w; w.x = cvtpk(s0[0], s0[1]); w.y = cvtpk(s0[2], s0[3]); w.z = cvtpk(s1[0], s1[1]); w.w = cvtpk(s1[2], s1[3]);
                        *(u32x4*)dst = w;
                    } else if (kind < 5) {
                        const u32x4 gn = *(const u32x4*)pn_, gd = *(const u32x4*)pd_;
                        m0[0] = bf_lo(gn.x) * __builtin_amdgcn_rcpf(bf_lo(gd.x)); m0[1] = bf_hi(gn.x) * __builtin_amdgcn_rcpf(bf_hi(gd.x));
                        m0[2] = bf_lo(gn.y) * __builtin_amdgcn_rcpf(bf_lo(gd.y)); m0[3] = bf_hi(gn.y) * __builtin_amdgcn_rcpf(bf_hi(gd.y));
                        m1[0] = bf_lo(gn.z) * __builtin_amdgcn_rcpf(bf_lo(gd.z)); m1[1] = bf_hi(gn.z) * __builtin_amdgcn_rcpf(bf_hi(gd.z));
                        m1[2] = bf_lo(gn.w) * __builtin_amdgcn_rcpf(bf_lo(gd.w)); m1[3] = bf_hi(gn.w) * __builtin_amdgcn_rcpf(bf_hi(gd.w));
                    } else {
                        const u32x4 g = *(const u32x4*)pn_;
                        u32x4 w; w.x = cvtpk(v0[0] * bf_lo(g.x), v0[1] * bf_hi(g.x)); w.y = cvtpk(v0[2] * bf_lo(g.y), v0[3] * bf_hi(g.y));
                        w.z = cvtpk(v1[0] * bf_lo(g.z), v1[1] * bf_hi(g.z)); w.w = cvtpk(v1[2] * bf_lo(g.w), v1[3] * bf_hi(g.w));
                        *(u32x4*)(mp + bj * 128) = w;
                    }
                    acc[ai][bj][m][0] = v0 * m0; acc[ai][bj][m][1] = v1 * m1;
                    asm volatile("" : "+v"(acc[ai][bj][m][0]), "+v"(acc[ai][bj][m][1]));
                    pn_ += 8192; pd_ += 8192; dst += 8192;
                    asm volatile("" : "+v"(pn_), "+v"(pd_), "+v"(dst));
                }
                mp += 16 * DM;
                asm volatile("" : "+v"(mp) :: "memory");
            }
            mp += 64 * DM;
        }
    }
};
__device__ __forceinline__ void p3_phase(Frame& F) {
    P3Sched S{(const char*)F.out, (const char*)(F.ws + WS_WTIN), (const char*)(F.ws + WS_WTBR), F.ws, F.G, F.bid};
    P3Epi E{F.ws + WS_GSTASH + (size_t)F.bid * 393216, (bf16_t*)(F.ws + WS_MIXED)};
    pg8::gemm_phase<P3Epi, P3Sched>(F.lds, S, E);
}

constexpr int P4_TILES = (TOK / 256) * 4 + 4;
struct P4Sched {
    const char* A; const char* WT; int G, c;
    __device__ __forceinline__ bool next(int i, pg8::GUnit& u) const {
        const int L = i * G + c; if (L >= P4_TILES) return false;
        int pm, pn; if (L < 1024) pg8::tile_order(L, TOK / 256, 4, pm, pn); else { pm = TOK / 256; pn = L - 1024; }
        u.pm = pm; u.pn = pn; u.kind = 0; u.a = A + (size_t)pm * 256 * (DM * 2); u.b = WT + (size_t)(256 * pn) * (DM * 2); u.nt = DM / 64;
        return true;
    }
};
struct P4Epi {
    const float* xp; const float* xs; float* out; float* rowsq;
    __device__ __forceinline__ void operator()(f32x4 (&acc)[2][2][4][2], const pg8::GUnit& u, int wr, int wc, int fr, int fq) const {
        const bool sample = (u.pm == TOK / 256);
#pragma unroll
        for (int ai = 0; ai < 2; ++ai)
#pragma unroll
            for (int m = 0; m < 4; ++m) {
                const int row = u.pm * 256 + ai * 128 + wr * 64 + m * 16 + fr;
                const bool valid = !sample || row < TOK + STOK;
                const float* xr = sample ? xs + (size_t)(valid ? row - TOK : 0) * DM : xp + (size_t)row * DM;
                float* orow = sample ? out + O_YS + (size_t)(valid ? row - TOK : 0) * DM : out + O_Y + (size_t)row * DM;
                float ss = 0.f;
#pragma unroll
                for (int bj = 0; bj < 2; ++bj) {
                    const int col = u.pn * 256 + bj * 128 + wc * 32 + 8 * fq;
                    const f32x4 x0 = *(const f32x4*)(xr + col), x1 = *(const f32x4*)(xr + col + 4);
                    const f32x4 h0 = acc[ai][bj][m][0] + x0, h1 = acc[ai][bj][m][1] + x1;
                    ss += (h0[0] * h0[0] + h0[1] * h0[1]) + (h0[2] * h0[2] + h0[3] * h0[3]) + (h1[0] * h1[0] + h1[1] * h1[1]) + (h1[2] * h1[2] + h1[3] * h1[3]);
                    if (valid) { *(f32x4*)(orow + col) = h0; *(f32x4*)(orow + col + 4) = h1; }
                    acc[ai][bj][m][0] = (f32x4){0.f, 0.f, 0.f, 0.f}; acc[ai][bj][m][1] = (f32x4){0.f, 0.f, 0.f, 0.f};
                }
                ss += __shfl_xor(ss, 16); ss += __shfl_xor(ss, 32);
                if (fq == 0) rowsq[(size_t)row * 16 + u.pn * 4 + wc] = ss;
                asm volatile("" ::: "memory");
            }
    }
};
__device__ __forceinline__ void p4_phase(Frame& F) {
    P4Sched S{(const char*)(F.ws + WS_MIXED), (const char*)(F.ws + WS_WTOUT), F.G, F.bid};
    P4Epi E{F.in[I_XP], F.in[I_XS], F.out, (float*)(F.ws + WS_ROWSQ)};
    pg8::gemm_phase<P4Epi, P4Sched>(F.lds, S, E);
}

__device__ __forceinline__ void p5_phase(Frame& F) {
    const int gw = F.bid * NWAVES + F.wave, NGW = F.G * NWAVES, lane = F.lane;
    const float* rowsq = (const float*)(F.ws + WS_ROWSQ);
    const f32x4* gr = (const f32x4*)F.in[I_NORM_F] + lane;
    f32x4 g[4];
#pragma unroll
    for (int j = 0; j < 4; ++j) g[j] = gr[64 * j];
    for (int m = gw; m < TOK + STOK; m += NGW) {
        float* orow = m < TOK ? F.out + O_Y + (size_t)m * DM : F.out + O_YS + (size_t)(m - TOK) * DM;
        const float part = (lane < 16) ? rowsq[(size_t)m * 16 + lane] : 0.f;
        const float r = 1.0f / sqrtf(wave_sum(part) * (1.f / DM) + RMS_EPS);
        f32x4* o = (f32x4*)orow + lane;
#pragma unroll
        for (int j = 0; j < 4; ++j) o[64 * j] = o[64 * j] * r * g[j];
    }
}
#ifndef MK_N_LAUNCHES
#define MK_N_LAUNCHES 1
#endif
constexpr int N_PHASES = 6;
__global__ void __launch_bounds__(NTHREADS, 2) mk_fwd(Args args) {
    extern __shared__ __attribute__((aligned(16))) unsigned char lds_raw[];
    Frame F;
    F.lds = (LAS unsigned char*)lds_raw;
    F.tid = threadIdx.x; F.lane = F.tid & 63; F.wave = __builtin_amdgcn_readfirstlane(F.tid >> 6);
    F.G = gridDim.x; F.bid = blockIdx.x;
    F.in = args.in; F.out = args.out; F.ws = args.ws;
    const int lo = args.ph_lo, hi = args.ph_hi;
#define IN(k) (lo <= (k) && (k) < hi)
#if MK_N_LAUNCHES == 1
#define GRID_SYNC() cg::this_grid().sync()
#else
#define GRID_SYNC() do {} while (0)
#endif
    if (IN(0)) { p0_prologue(F); if (IN(1)) GRID_SYNC(); }
    if (IN(1)) { p1_phase(F); if (IN(2)) GRID_SYNC(); }
    if (IN(2)) { p2_phase(F); if (IN(3)) GRID_SYNC(); }
    if (IN(3)) { p3_phase(F); if (IN(4)) GRID_SYNC(); }
    if (IN(4)) { p4_phase(F); if (IN(5)) GRID_SYNC(); }
    if (IN(5)) { p5_phase(F); }
#undef IN
}

extern "C" void kernel_launch(void* const* d_in, const int* in_sizes, int n_in, void* d_out, int out_size, void* d_ws, size_t ws_size, hipStream_t stream) {
    static int grid = 0;
    if (grid == 0) {
        if (n_in != 24 || out_size != (int)O_TOTAL || ws_size < WS_END) { fprintf(stderr, "kernel_launch: unexpected problem (n_in %d, out %d, ws %zu)\n", n_in, out_size, ws_size); grid = -1; return; }
        int dev = 0, cus = 0, per_cu = 0;
        if (hipGetDevice(&dev) != hipSuccess || hipDeviceGetAttribute(&cus, hipDeviceAttributeMultiprocessorCount, dev) != hipSuccess) { grid = -1; return; }
        if (hipFuncSetAttribute((const void*)mk_fwd, hipFuncAttributeMaxDynamicSharedMemorySize, LDS_BYTES) != hipSuccess) { fprintf(stderr, "kernel_launch: hipFuncSetAttribute failed\n"); grid = -1; return; }
        if (hipOccupancyMaxActiveBlocksPerMultiprocessor(&per_cu, (const void*)mk_fwd, NTHREADS, LDS_BYTES) != hipSuccess || per_cu < 1) { fprintf(stderr, "kernel_launch: occupancy query says %d\n", per_cu); per_cu = 1; }
        (void)hipGetLastError();
        grid = cus;
    }
    if (grid < 0) return;
    Args a{};
    for (int i = 0; i < 24; ++i) a.in[i] = (const float*)d_in[i];
    a.out = (float*)d_out; a.ws = (unsigned char*)d_ws;
#if MK_N_LAUNCHES == 1
    a.ph_lo = 0; a.ph_hi = N_PHASES;
    void* kargs[] = {&a};
    hipError_t e = hipLaunchCooperativeKernel((const void*)mk_fwd, dim3(grid), dim3(NTHREADS), kargs, LDS_BYTES, stream);
    if (e != hipSuccess) fprintf(stderr, "kernel_launch: cooperative launch failed: %s (grid %d)\n", hipGetErrorString(e), grid);
#else
    for (int p = 0; p < N_PHASES; ++p) { a.ph_lo = p; a.ph_hi = p + 1; hipLaunchKernelGGL(mk_fwd, dim3(grid), dim3(NTHREADS), LDS_BYTES, stream, a); }
#endif
}
```

```cpp
#include <hip/hip_runtime.h>
#include <hip/hip_cooperative_groups.h>
#include <cstdint>
#include <cstdio>
namespace cg = cooperative_groups;

#define LAS __attribute__((address_space(3)))
#define GAS __attribute__((address_space(1)))
typedef unsigned short bf16_t;
typedef short bf16x8 __attribute__((ext_vector_type(8)));
typedef short s16x4 __attribute__((ext_vector_type(4)));
typedef float f32x2 __attribute__((ext_vector_type(2)));
typedef float f32x4 __attribute__((ext_vector_type(4)));
typedef float f32x16 __attribute__((ext_vector_type(16)));
typedef unsigned u32x2 __attribute__((ext_vector_type(2)));
typedef unsigned u32x4 __attribute__((ext_vector_type(4)));
typedef __bf16 bf16x2_t __attribute__((ext_vector_type(2)));

constexpr int DM = 1024;
constexpr int NBATCH = 16, SEQ = 4096, TOK = NBATCH * SEQ;
constexpr int SBATCH = 8, STEP = 16, STOK = SBATCH * STEP;
constexpr int PAST = 4096, APAST = 512;
constexpr int ROWS = TOK + 256;
constexpr int NMEM = 256, MEMROWS = NBATCH * NMEM;
constexpr int BW = 512;
constexpr int NPROJ = 5120;
constexpr float RMS_EPS = 1e-6f;
constexpr float LOG2E = 1.4426950408889634f;
constexpr float LAM_INIT = 0.2f;
constexpr int SKA_ROWS = 576, SKB_ROWS = 4160;

constexpr size_t O_Y = 0, O_YS = 67108864, O_AK = O_YS + 131072, O_AV = O_AK + 4194304, O_BK = O_AV + 4194304, O_BV = O_BK + 33554432,
                 O_MK = O_BV + 33554432, O_MV = O_MK + 2097152, O_SAK = O_MV + 2097152, O_SAV = O_SAK + 65536, O_SBK = O_SAV + 65536, O_SBV = O_SBK + 65536,
                 O_TOTAL = O_SBV + 65536;
static_assert(O_TOTAL == 147193856, "d_out size");

constexpr size_t MiB = 1u << 20;
constexpr size_t WS_CTL = 0;
constexpr size_t WS_WTIN = 1 * MiB;
constexpr size_t WS_WTBR = 19 * MiB;
constexpr size_t WS_WTOUT = 25 * MiB;
constexpr size_t WS_ROPE = 27 * MiB;
constexpr size_t WS_ROWSQ = 29 * MiB;
constexpr int SLD = 1024;
constexpr size_t WS_MKV = 34 * MiB;
constexpr size_t WS_SKVA = 42 * MiB;
constexpr size_t WS_SMKV = 51 * MiB;
constexpr size_t WS_SKVB = 55 * MiB;
constexpr size_t WS_SLOT0 = 120 * MiB, PAIR_BYTES = (size_t)ROWS * SLD * 2;
enum Slot { S_AK = 0, S_AV, S_BQ, S_BK, S_AQ, S_BV, S_MQ, S_AZ, S_BZ, S_MZ, S_N };
constexpr size_t WS_MIXED = WS_SLOT0;
constexpr size_t WS_GSTASH = WS_SLOT0 + PAIR_BYTES;
constexpr size_t WS_END = WS_SLOT0 + (S_N / 2) * PAIR_BYTES;
static_assert(WS_END <= 1024 * MiB, "d_ws map");
constexpr size_t H_BYTES = (size_t)(ROWS + MEMROWS) * DM * 2;
static_assert(H_BYTES <= (size_t)O_YS * 4, "H fits the y_prompt region");

constexpr int CW_LAM = 16;
constexpr int CW_QUEUE = 64;
constexpr int CW_BAR = 4096;
constexpr size_t CTL_ZERO_BYTES = 65536;

constexpr int LDS_BYTES = 163840;
constexpr int L_BARST = LDS_BYTES - 64;
constexpr int NWAVES = 8, NTHREADS = 512;

__device__ __forceinline__ unsigned cvtpk(float lo, float hi) { f32x2 v = {lo, hi}; bf16x2_t b = __builtin_convertvector(v, bf16x2_t); return __builtin_bit_cast(unsigned, b); }
__device__ __forceinline__ float bf_lo(unsigned u) { return __uint_as_float(u << 16); }
__device__ __forceinline__ float bf_hi(unsigned u) { return __uint_as_float(u & 0xffff0000u); }
__device__ __forceinline__ float wave_sum(float v) {
#pragma unroll
    for (int o = 1; o < 64; o <<= 1) v += __shfl_xor(v, o);
    return v;
}
__device__ __forceinline__ float fast_sigmoid(float x) { return __builtin_amdgcn_rcpf(1.0f + __builtin_amdgcn_exp2f(-x * LOG2E)); }
#define LDS_WAIT() asm volatile("s_waitcnt lgkmcnt(0)" ::: "memory")
#define VM_WAIT() asm volatile("s_waitcnt vmcnt(0)" ::: "memory")
namespace pg8 {
constexpr int BM = 256, BK = 64, HALF = 128, HTB = HALF * BK * 2  , STAGE_BYTES = 8 * HTB;
__host__ __device__ __forceinline__ int lds_byte(int r, int c) { const int st = (r >> 4) * 2 + (c >> 5), rr = r & 15, cc = c & 31, ob = rr * 64 + cc * 2; return st * 1024 + (ob ^ (((ob >> 9) & 1) << 5)); }
__host__ __device__ __forceinline__ void stage_rc(int b, int& R, int& C) { const int st = b / 1024, sb = b % 1024, swz = sb ^ (((sb >> 9) & 1) << 5); R = (st >> 1) * 16 + swz / 64; C = (st & 1) * 32 + (swz % 64) / 2; }
__host__ __device__ __forceinline__ int perm32(int rho) { const int n = rho >> 4, i = rho & 15; return 8 * (i >> 2) + 4 * n + (i & 3); }

constexpr unsigned LD = 2048;
struct GUnit { const char* a; const char* b; int nt; int kind; int pm, pn; };

template <class Epi, class Sched>
__device__ __forceinline__ void gemm_phase(LAS unsigned char* lds, const Sched& S, const Epi& E) {
    const int tid = threadIdx.x, wid = __builtin_amdgcn_readfirstlane(tid >> 6), lane = tid & 63, wr = wid >> 2, wc = wid & 3, fr = lane & 15, fq = lane >> 4;
    unsigned RA[2], RB[2], C2[2];
#pragma unroll
    for (int i = 0; i < 2; ++i) { int R, C; stage_rc(tid * 16 + i * 8192, R, C); RA[i] = (unsigned)R; RB[i] = (unsigned)((R & ~31) + perm32(R & 31)); C2[i] = (unsigned)(C * 2); }
    const size_t kstep = (size_t)(BK * 2);
    const unsigned ldsw = (unsigned)wid * 1024u;
    const int aoff = lds_byte(wr * 64 + fr, fq * 8), boff = lds_byte(wc * 32 + fr, fq * 8);
#define PG8_SA(b, h) (((b) * 2 + (h)) * HTB)
#define PG8_SB(b, h) ((4 + (b) * 2 + (h)) * HTB)
#define PG8_STAGE(bufoff, gbase, RV) do { _Pragma("unroll") for (int _i = 0; _i < 2; ++_i) \
        __builtin_amdgcn_global_load_lds((const unsigned*)((const char*)(gbase) + (size_t)(RV[_i] * LD + C2[_i])), (LAS unsigned*)(lds + (bufoff) + ldsw + _i * 8192), 16, 0, 0); } while (0)
#define PG8_LDA(dst, b, h) do { _Pragma("unroll") for (int m = 0; m < 4; ++m) _Pragma("unroll") for (int k = 0; k < 2; ++k) dst[m][k] = *(const LAS bf16x8*)(lds + PG8_SA(b, h) + aoff + m * 2048 + k * 1024); } while (0)
#define PG8_LDB(dst, b, h) do { _Pragma("unroll") for (int n = 0; n < 2; ++n) _Pragma("unroll") for (int k = 0; k < 2; ++k) dst[n][k] = *(const LAS bf16x8*)(lds + PG8_SB(b, h) + boff + n * 2048 + k * 1024); } while (0)
#define PG8_MMA(ai, bj, At, Bt) do { __builtin_amdgcn_s_setprio(1); _Pragma("unroll") for (int m = 0; m < 4; ++m) _Pragma("unroll") for (int n = 0; n < 2; ++n) _Pragma("unroll") for (int k = 0; k < 2; ++k) \
        acc[ai][bj][m][n] = __builtin_amdgcn_mfma_f32_16x16x32_bf16(Bt[n][k], At[m][k], acc[ai][bj][m][n], 0, 0, 0); __builtin_amdgcn_s_setprio(0); } while (0)
#define PG8_WAIT_V(n) asm volatile("s_waitcnt vmcnt(" #n ")" ::: "memory")
#define PG8_WAIT_L(n) asm volatile("s_waitcnt lgkmcnt(" #n ")" ::: "memory")
#define PG8_BAR __builtin_amdgcn_s_barrier()
#define PG8_SCHED __builtin_amdgcn_sched_barrier(0)
    GUnit cur, nxt; int ui = 0;
    if (!S.next(0, cur)) return;
    f32x4 acc[2][2][4][2];
#pragma unroll
    for (int a = 0; a < 2; ++a)
#pragma unroll
        for (int b = 0; b < 2; ++b)
#pragma unroll
            for (int m = 0; m < 4; ++m)
#pragma unroll
                for (int n = 0; n < 2; ++n) acc[a][b][m][n] = (f32x4){0.f, 0.f, 0.f, 0.f};
    bf16x8 At[4][2], B0[2][2], B1[2][2];
    const char* cA = cur.a; const char* cB = cur.b;
    {
        constexpr size_t hA = (size_t)HALF * LD, hB = (size_t)HALF * LD;
        PG8_STAGE(PG8_SB(0, 0), cB, RB); PG8_STAGE(PG8_SB(0, 1), cB + hB, RB); PG8_STAGE(PG8_SA(0, 0), cA, RA); PG8_STAGE(PG8_SA(0, 1), cA + hA, RA);
        if (wr == 1) PG8_BAR;
        PG8_WAIT_V(2); PG8_BAR;
        PG8_STAGE(PG8_SB(1, 0), cB + kstep, RB); PG8_STAGE(PG8_SA(1, 0), cA + kstep, RA); PG8_STAGE(PG8_SB(1, 1), cB + hB + kstep, RB);
        PG8_WAIT_V(6); PG8_BAR;
    }
    for (;;) {
        const bool has_next = S.next(ui + 1, nxt);
        const char* nA = has_next ? nxt.a : cA; const char* nB = has_next ? nxt.b : cB;
        const int nt = cur.nt;
        constexpr size_t hA = (size_t)HALF * LD, hB = (size_t)HALF * LD, hA2 = hA, hB2 = hB;
        for (int t = 0; t < nt; t += 2) {
            const bool last = (t == nt - 2);
            const char* a1 = cA + (size_t)(t + 1) * kstep;
            const char* a2 = last ? nA : cA + (size_t)(t + 2) * kstep; const char* b2 = last ? nB : cB + (size_t)(t + 2) * kstep;
            const char* a3 = a2 + kstep; const char* b3 = b2 + kstep;
            PG8_LDB(B0, 0, 0); PG8_LDB(B1, 0, 1); PG8_SCHED; PG8_LDA(At, 0, 0); PG8_STAGE(PG8_SA(1, 1), a1 + hA, RA);
            PG8_WAIT_V(8); PG8_WAIT_L(0); PG8_BAR; PG8_MMA(0, 0, At, B0); PG8_MMA(0, 1, At, B1); PG8_BAR; PG8_SCHED;
            PG8_LDA(At, 0, 1); PG8_STAGE(PG8_SB(0, 0), b2, RB); PG8_STAGE(PG8_SB(0, 1), b2 + hB2, RB); PG8_STAGE(PG8_SA(0, 0), a2, RA);
            PG8_WAIT_V(8); PG8_WAIT_L(0); PG8_BAR; PG8_MMA(1, 0, At, B0); PG8_MMA(1, 1, At, B1); PG8_BAR; PG8_SCHED;
            PG8_LDB(B0, 1, 0); PG8_LDB(B1, 1, 1); PG8_SCHED; PG8_LDA(At, 1, 0); PG8_STAGE(PG8_SA(0, 1), a2 + hA2, RA);
            PG8_WAIT_V(8); PG8_WAIT_L(0); PG8_BAR; PG8_MMA(0, 0, At, B0); PG8_MMA(0, 1, At, B1); PG8_BAR; PG8_SCHED;
            PG8_LDA(At, 1, 1); PG8_STAGE(PG8_SB(1, 0), b3, RB); PG8_STAGE(PG8_SB(1, 1), b3 + hB2, RB); PG8_STAGE(PG8_SA(1, 0), a3, RA);
            PG8_WAIT_V(8); PG8_WAIT_L(0); PG8_BAR; PG8_MMA(1, 0, At, B0); PG8_MMA(1, 1, At, B1); PG8_BAR; PG8_SCHED;
        }
        if (wr == 0) PG8_BAR;
        E(acc, cur, wr, wc, fr, fq);
        if (!has_next) break;
        cur = nxt; cA = nA; cB = nB; ++ui;
        if (wr == 1) PG8_BAR;
    }
    PG8_WAIT_V(0);
    PG8_BAR;
#undef PG8_SA
#undef PG8_SB
#undef PG8_STAGE
#undef PG8_LDA
#undef PG8_LDB
#undef PG8_MMA
#undef PG8_WAIT_V
#undef PG8_WAIT_L
#undef PG8_BAR
#undef PG8_SCHED
}
__device__ __forceinline__ void tile_order(int L, int nM, int nN, int& pm, int& pn) {
    constexpr int NXCD = 8, WGM = 8;
    const int nwg = nM * nN; int wgid = L; { const int q = nwg / NXCD, r = nwg % NXCD, xcd = wgid % NXCD, off = wgid / NXCD; wgid = (xcd < r ? xcd * (q + 1) : r * (q + 1) + (xcd - r) * q) + off; }
    const int nig = WGM * nN, gid = wgid / nig, fm = gid * WGM, gsz = (nM - fm) < WGM ? (nM - fm) : WGM;
    pm = fm + ((wgid % nig) % gsz); pn = (wgid % nig) / gsz;
}
}
typedef GAS unsigned gu32;
#define RLX_AGENT __ATOMIC_RELAXED, __HIP_MEMORY_SCOPE_AGENT
#define XB_TMO      128
#define XB_XCNT(j)  (256  + 64 * (j))
#define XB_XSUB(j)  (1280 + 64 * (j))
#define XB_XGEN(j)  (2304 + 64 * (j))
#define XB_TOP      3328
#define XB_TOPGEN   3392
#define XCD_BAR_WORDS 3456
#define XB_SPIN_CAP (1u << 18)

__device__ __forceinline__ unsigned xb_ld(unsigned* p)              { return __hip_atomic_load(p, __ATOMIC_RELAXED, __HIP_MEMORY_SCOPE_AGENT); }
__device__ __forceinline__ unsigned xb_add(unsigned* p, unsigned v) { return __hip_atomic_fetch_add(p, v, __ATOMIC_RELAXED, __HIP_MEMORY_SCOPE_AGENT); }
__device__ __forceinline__ unsigned xb_xcc_id() { return (unsigned)__builtin_amdgcn_s_getreg((3 << 11) | 20) & 0xFu; }
#define XB_SPIN(cond, bar) do { unsigned _sp = 0; while (cond) { __builtin_amdgcn_s_sleep(1); \
    if ((++_sp & 255u) == 0u) { if (xb_ld(&(bar)[XB_TMO])) break; if (_sp > XB_SPIN_CAP) { atomicAdd(&(bar)[XB_TMO], 1u); break; } } } } while (0)

struct XcdBarrier {
    unsigned* bar; unsigned x;
    volatile LAS unsigned* st;
};

__device__ __forceinline__ XcdBarrier xcd_barrier_post(unsigned* bar, volatile LAS unsigned* st) {
    XcdBarrier b; b.bar = bar; b.x = xb_xcc_id(); b.st = st;
    if (threadIdx.x == 0) (void)xb_add(&bar[XB_XCNT(b.x)], 1u);
    return b;
}
__device__ __forceinline__ void xcd_barrier_complete(unsigned* bar, unsigned x, unsigned& nloc, unsigned& nx) {
    const unsigned G = gridDim.x * gridDim.y * gridDim.z;
    unsigned sum, cnt, mine, sp = 0u;
    for (;;) {
        sum = 0u; cnt = 0u; mine = 0u;
#pragma unroll
        for (unsigned j = 0; j < 16; ++j) { const unsigned c = xb_ld(&bar[XB_XCNT(j)]); sum += c; cnt += (c > 0u) ? 1u : 0u; mine = (j == x) ? c : mine; }
        if (sum == G) break;
        __builtin_amdgcn_s_sleep(1);
        if ((++sp & 255u) == 0u) { if (xb_ld(&bar[XB_TMO])) break; if (sp > XB_SPIN_CAP) { atomicAdd(&bar[XB_TMO], 1u); break; } }
    }
    nloc = mine > 0u ? mine : 1u; nx = cnt > 0u ? cnt : 1u;
}

__device__ __forceinline__ void xcd_barrier(const XcdBarrier& b) {
    asm volatile("s_waitcnt vmcnt(0)" ::: "memory");
    __syncthreads();
    if (threadIdx.x == 0) {
        unsigned* bar = b.bar;
        __builtin_amdgcn_s_waitcnt(0);
        unsigned nloc = b.st[0], nx = b.st[1];
        if (nloc == 0u) { xcd_barrier_complete(bar, b.x, nloc, nx); b.st[0] = nloc; b.st[1] = nx; }
        const unsigned old = xb_add(&bar[XB_XSUB(b.x)], 1u);
        const unsigned gen = old / nloc;
        if (old + 1u == (gen + 1u) * nloc) {
            __builtin_amdgcn_fence(__ATOMIC_RELEASE, "agent");
            asm volatile("s_waitcnt vmcnt(0)" ::: "memory");
            const unsigned og = xb_add(&bar[XB_TOP], 1u);
            const unsigned tg = og / nx;
            if (og + 1u == (tg + 1u) * nx) xb_add(&bar[XB_TOPGEN], 1u);
            else XB_SPIN(xb_ld(&bar[XB_TOPGEN]) == tg, bar);
            __builtin_amdgcn_fence(__ATOMIC_ACQUIRE, "agent");
            xb_add(&bar[XB_XGEN(b.x)], 1u);
            asm volatile("s_waitcnt vmcnt(0)" ::: "memory");
        } else {
            XB_SPIN(xb_ld(&bar[XB_XGEN(b.x)]) == gen, bar);
            __builtin_amdgcn_fence(__ATOMIC_ACQUIRE, "agent");
            asm volatile("s_waitcnt vmcnt(0)" ::: "memory");
        }
    }
    __syncthreads();
}
struct Args {
    const float* in[24];
    float* out; unsigned char* ws;
    int ph_lo, ph_hi;
};
struct Frame {
    LAS unsigned char* lds;
    int tid, lane, wave, G, bid;
    const float* const* in;
    float* out; unsigned char* ws;
};
enum In { I_XP = 0, I_XS, I_CAK, I_CAV, I_CBK, I_CBV, I_CMK, I_CMV, I_MEM, I_NORM_IN, I_W_IN, I_RELB, I_LQ1, I_LK1, I_LQ2, I_LK2, I_SUBLN, I_NORM_MEM, I_W_MEMKV, I_WBA, I_WBB, I_WBM, I_WOUT, I_NORM_F };

__device__ __forceinline__ bf16_t* slot_ptr(unsigned char* ws, int s) { return (bf16_t*)(ws + WS_SLOT0 + (size_t)(s >> 1) * PAIR_BYTES) + (s & 1) * BW; }

__device__ __forceinline__ void p0_transpose_item(const float* W, int N, bf16_t* WT, int k0, int n0, int dn0, LAS float* scr, int lane) {
#pragma unroll 8
    for (int i = 0; i < 32; ++i) { const int kk = 2 * i + (lane >> 5); scr[kk * 33 + (lane & 31)] = W[(size_t)(k0 + kk) * N + n0 + (lane & 31)]; }
    LDS_WAIT(); asm volatile("" ::: "memory");
    const int c = lane & 7;
#pragma unroll
    for (int j = 0; j < 4; ++j) { const int n = (lane >> 3) + 8 * j; const LAS float* s = scr + (8 * c) * 33 + n;
        u32x4 o; o.x = cvtpk(s[0 * 33], s[1 * 33]); o.y = cvtpk(s[2 * 33], s[3 * 33]); o.z = cvtpk(s[4 * 33], s[5 * 33]); o.w = cvtpk(s[6 * 33], s[7 * 33]);
        *(u32x4*)(WT + (size_t)(dn0 + n) * SLD + k0 + 8 * c) = o; }
    LDS_WAIT(); asm volatile("" ::: "memory");
}
__device__ __forceinline__ int win_dest(int n0) {
    const int tile = n0 >> 8; if (tile < 8 || tile > 11) return n0;
    const int tb = (n0 & 255) >> 5;
    return tile * 256 + 32 * (4 * (tb & 1) + (tb >> 1));
}
__device__ __forceinline__ void rms_row_to_bf16(const float* xrow, const float* g, bf16_t* orow, int lane) {
    const f32x4* xr = (const f32x4*)xrow + lane; const f32x4* gr = (const f32x4*)g + lane;
    f32x4 v[4]; float s = 0.f;
#pragma unroll
    for (int j = 0; j < 4; ++j) { v[j] = xr[64 * j]; s += (v[j].x * v[j].x + v[j].y * v[j].y) + (v[j].z * v[j].z + v[j].w * v[j].w); }
    const float r = 1.0f / sqrtf(wave_sum(s) * (1.f / DM) + RMS_EPS);
    u32x2* o8 = (u32x2*)orow + lane;
#pragma unroll
    for (int j = 0; j < 4; ++j) { const f32x4 gg = gr[64 * j]; u32x2 w; w.x = cvtpk(v[j].x * r * gg.x, v[j].y * r * gg.y); w.y = cvtpk(v[j].z * r * gg.z, v[j].w * r * gg.w); o8[64 * j] = w; }
}
__device__ __forceinline__ void cvt_cache(const float* src, bf16_t* dst, int nb, int rows, int drows, int gtid, int gthreads) {
    const int per_b = rows * 64, total = nb * per_b;
    for (int it = gtid; it < total; it += gthreads) {
        const int b = it / per_b, r = it - b * per_b;
        const f32x4* s = (const f32x4*)(src + (size_t)it * 8); const f32x4 a = s[0], c = s[1];
        u32x4 o; o.x = cvtpk(a.x, a.y); o.y = cvtpk(a.z, a.w); o.z = cvtpk(c.x, c.y); o.w = cvtpk(c.z, c.w);
        *(u32x4*)(dst + ((size_t)b * drows + (r >> 6)) * SLD + (r & 63) * 8) = o;
    }
}
__device__ __forceinline__ void zero_rows(bf16_t* dst, int nb, int r0, int r1, int drows, int gtid, int gthreads) {
    const int per_b = (r1 - r0) * 64, total = nb * per_b;
    for (int it = gtid; it < total; it += gthreads) { const int b = it / per_b, r = it - b * per_b; *(u32x4*)(dst + ((size_t)b * drows + r0 + (r >> 6)) * SLD + (r & 63) * 8) = (u32x4){0u, 0u, 0u, 0u}; }
}
__device__ __forceinline__ void p0_prologue(Frame& F) {
    LAS float* scr = (LAS float*)(F.lds + F.wave * 16384);
    const int gw = F.bid * NWAVES + F.wave, NGW = F.G * NWAVES, lane = F.lane;
    const int gtid = F.bid * NTHREADS + F.tid, NGT = F.G * NTHREADS;
    unsigned char* ws = F.ws;
    bf16_t* WTIN = (bf16_t*)(ws + WS_WTIN); bf16_t* WTBR = (bf16_t*)(ws + WS_WTBR); bf16_t* WTOUT = (bf16_t*)(ws + WS_WTOUT);
    constexpr int I_IN = (DM / 64) * (8192 / 32), I_MEMKV = (DM / 64) * (1024 / 32), I_BR = (BW / 64) * (DM / 32), I_OUT = (DM / 64) * (DM / 32);
    constexpr int NITEMS = I_IN + I_MEMKV + 3 * I_BR + I_OUT;
    for (int it = gw; it < NITEMS; it += NGW) {
        int r = it;
        if (r < I_IN) { const int nb = r % 256, kb = r / 256; p0_transpose_item(F.in[I_W_IN], 8192, WTIN, 64 * kb, 32 * nb, win_dest(32 * nb), scr, lane); continue; } r -= I_IN;
        if (r < I_MEMKV) { const int nb = r % 32, kb = r / 32; p0_transpose_item(F.in[I_W_MEMKV], 1024, WTIN + (size_t)8192 * DM, 64 * kb, 32 * nb, 32 * nb, scr, lane); continue; } r -= I_MEMKV;
        if (r < 3 * I_BR) { const int br = r / I_BR, q = r % I_BR, nb = q % 32, kb = q / 32; p0_transpose_item(F.in[I_WBA + br], DM, WTBR + (size_t)br * DM * SLD, 64 * kb, 32 * nb, 32 * nb, scr, lane); continue; } r -= 3 * I_BR;
        { const int nb = r % 32, kb = r / 32; p0_transpose_item(F.in[I_WOUT], DM, WTOUT, 64 * kb, 32 * nb, 32 * nb, scr, lane); }
    }
    bf16_t* H = (bf16_t*)F.out;
    for (int m = gw; m < ROWS + MEMROWS; m += NGW) {
        bf16_t* orow = H + (size_t)m * DM;
        if (m < TOK) rms_row_to_bf16(F.in[I_XP] + (size_t)m * DM, F.in[I_NORM_IN], orow, lane);
        else if (m < TOK + STOK) rms_row_to_bf16(F.in[I_XS] + (size_t)(m - TOK) * DM, F.in[I_NORM_IN], orow, lane);
        else if (m < ROWS) { u32x2* o8 = (u32x2*)orow + lane; for (int j = 0; j < 4; ++j) o8[64 * j] = (u32x2){0u, 0u}; }
        else rms_row_to_bf16(F.in[I_MEM] + (size_t)(m - ROWS) * DM, F.in[I_NORM_MEM], orow, lane);
    }
    cvt_cache(F.in[I_CAK], (bf16_t*)(ws + WS_SKVA), SBATCH, APAST, SKA_ROWS, gtid, NGT);
    cvt_cache(F.in[I_CAV], (bf16_t*)(ws + WS_SKVA) + BW, SBATCH, APAST, SKA_ROWS, gtid, NGT);
    cvt_cache(F.in[I_CBK], (bf16_t*)(ws + WS_SKVB), SBATCH, PAST, SKB_ROWS, gtid, NGT);
    cvt_cache(F.in[I_CBV], (bf16_t*)(ws + WS_SKVB) + BW, SBATCH, PAST, SKB_ROWS, gtid, NGT);
    cvt_cache(F.in[I_CMK], (bf16_t*)(ws + WS_SMKV), SBATCH, NMEM, NMEM, gtid, NGT);
    cvt_cache(F.in[I_CMV], (bf16_t*)(ws + WS_SMKV) + BW, SBATCH, NMEM, NMEM, gtid, NGT);
    zero_rows((bf16_t*)(ws + WS_SKVA), SBATCH, APAST + STEP, SKA_ROWS, SKA_ROWS, gtid, NGT);
    zero_rows((bf16_t*)(ws + WS_SKVA) + BW, SBATCH, APAST + STEP, SKA_ROWS, SKA_ROWS, gtid, NGT);
    zero_rows((bf16_t*)(ws + WS_SKVB), SBATCH, PAST + STEP, SKB_ROWS, SKB_ROWS, gtid, NGT);
    zero_rows((bf16_t*)(ws + WS_SKVB) + BW, SBATCH, PAST + STEP, SKB_ROWS, SKB_ROWS, gtid, NGT);
    float* rope = (float*)(ws + WS_ROPE);
    for (int it = gtid; it < (PAST + STEP) * 32; it += NGT) {
        const int pos = it >> 5, i = it & 31;
        const float inv = 1.0f / powf(10000.0f, (float)(2 * i) / 64.0f);
        const float ang = (float)pos * inv;
        rope[pos * 64 + i] = cosf(ang); rope[pos * 64 + 32 + i] = sinf(ang);
    }
    if (F.bid == 0) {
        unsigned* ctl = (unsigned*)(ws + WS_CTL);
        if (F.wave == 0) {
            const float a = F.in[I_LQ1][lane] * F.in[I_LK1][lane], b = F.in[I_LQ2][lane] * F.in[I_LK2][lane];
            const float sa = wave_sum(a), sb = wave_sum(b);
            if (lane == 0) ((float*)ctl)[CW_LAM] = expf(sa) - expf(sb) + LAM_INIT;
        }
        if (F.wave == 1 && lane < 16) { ctl[CW_QUEUE + 64 * lane] = 0u; ctl[CW_QUEUE + 1024 + 64 * lane] = 0u; }
    }
}

constexpr int P1_NM = TOK / 256, P1_NN = NPROJ / 256;
constexpr int P1_MAIN = P1_NM * P1_NN, P1_SAMPLE = P1_NN, P1_MEMKV = (MEMROWS / 256) * 4, P1_UNITS = P1_MAIN + P1_SAMPLE + P1_MEMKV;
struct P1Sched {
    const char* H; const char* WT; int G, c;
    __device__ __forceinline__ bool next(int i, pg8::GUnit& u) const {
        const int L = i * G + c; if (L >= P1_UNITS) return false;
        int pm, pn, kind = 0; int brow;
        if (L < P1_MAIN) { pg8::tile_order(L, P1_NM, P1_NN, pm, pn); brow = 256 * pn; }
        else if (L < P1_MAIN + P1_SAMPLE) { pm = P1_NM; pn = L - P1_MAIN; brow = 256 * pn; }
        else { const int e = L - P1_MAIN - P1_SAMPLE; pm = (ROWS / 256) + (e >> 2); pn = e & 3; brow = 8192 + 256 * pn; kind = 1; }
        u.a = H + (size_t)pm * 256 * (DM * 2); u.b = WT + (size_t)brow * (DM * 2); u.nt = DM / 64; u.kind = kind; u.pm = pm; u.pn = pn;
        return true;
    }
};
struct P1Epi {
    unsigned char* ws; float* out; const float* rope; int dry;
    __device__ __forceinline__ void operator()(f32x4 (&acc)[2][2][4][2], const pg8::GUnit& u, int wr, int wc, int fr, int fq) const {
        const int pn = u.pn;
        if (dry) {
#pragma unroll
            for (int ai = 0; ai < 2; ++ai)
#pragma unroll
                for (int m = 0; m < 4; ++m)
#pragma unroll
                    for (int bj = 0; bj < 2; ++bj) { asm volatile("" :: "v"(acc[ai][bj][m][0]), "v"(acc[ai][bj][m][1])); acc[ai][bj][m][0] = (f32x4){0.f, 0.f, 0.f, 0.f}; acc[ai][bj][m][1] = (f32x4){0.f, 0.f, 0.f, 0.f}; }
            return;
        }
        if (u.kind == 1) {
            const int half = pn >> 1; bf16_t* dstb = (bf16_t*)(ws + WS_MKV) + half * BW; float* dstf = out + (half ? O_MV : O_MK);
#pragma unroll
            for (int ai = 0; ai < 2; ++ai)
#pragma unroll
                for (int m = 0; m < 4; ++m) {
                    const int mrow = (u.pm - ROWS / 256) * 256 + ai * 128 + wr * 64 + m * 16 + fr;
#pragma unroll
                    for (int bj = 0; bj < 2; ++bj) {
                        const int col = (pn & 1) * 256 + bj * 128 + wc * 32 + 8 * fq; const f32x4 v0 = acc[ai][bj][m][0], v1 = acc[ai][bj][m][1];
                        u32x4 w; w.x = cvtpk(v0[0], v0[1]); w.y = cvtpk(v0[2], v0[3]); w.z = cvtpk(v1[0], v1[1]); w.w = cvtpk(v1[2], v1[3]);
                        *(u32x4*)(dstb + (size_t)mrow * SLD + col) = w;
                        float* fo = dstf + (size_t)mrow * BW + col; *(f32x4*)fo = v0; *(f32x4*)(fo + 4) = v1;
                        acc[ai][bj][m][0] = (f32x4){0.f, 0.f, 0.f, 0.f}; acc[ai][bj][m][1] = (f32x4){0.f, 0.f, 0.f, 0.f};
                    }
                }
            return;
        }
        const int creg = pn >> 1;
        const int region = creg == 0 ? S_AQ : creg == 1 ? S_AK : creg == 2 ? S_AV : creg == 3 ? S_AZ : creg == 4 ? S_BQ : creg == 5 ? S_BK : creg == 6 ? S_BV : creg == 7 ? S_BZ : creg == 8 ? S_MQ : S_MZ;
        const bool is_rope = (region == S_BQ || region == S_BK);
        const bool is_silu = (region == S_AZ || region == S_BZ || region == S_MZ);
        const float scale = (region == S_AQ || region == S_BQ) ? 0.125f * LOG2E : (region == S_MQ ? 0.08838834764831845f * LOG2E : 1.0f);
        const int fmode = (region == S_AK || region == S_AV) ? 1 : ((region == S_BK || region == S_BV) ? 2 : 0);
        const bool sample = (u.pm == P1_NM);
        bf16_t* slot = slot_ptr(ws, region);
        float* fprompt = out + (region == S_AK ? O_AK : region == S_AV ? O_AV : region == S_BK ? O_BK : O_BV);
        float* fsample = out + (region == S_AK ? O_SAK : region == S_AV ? O_SAV : region == S_BK ? O_SBK : O_SBV);
        bf16_t* scache = (bf16_t*)(ws + ((region == S_AK || region == S_AV) ? WS_SKVA : WS_SKVB)) + ((region == S_AV || region == S_BV) ? BW : 0);
        const int crows = (fmode == 1) ? SKA_ROWS : SKB_ROWS, cpast = (fmode == 1) ? APAST : PAST;
#pragma unroll
        for (int ai = 0; ai < 2; ++ai)
#pragma unroll
            for (int m = 0; m < 4; ++m) {
                const int row = u.pm * 256 + ai * 128 + wr * 64 + m * 16 + fr;
                f32x4 v[2][2];
#pragma unroll
                for (int bj = 0; bj < 2; ++bj) { v[bj][0] = acc[ai][bj][m][0]; v[bj][1] = acc[ai][bj][m][1];
                    acc[ai][bj][m][0] = (f32x4){0.f, 0.f, 0.f, 0.f}; acc[ai][bj][m][1] = (f32x4){0.f, 0.f, 0.f, 0.f}; }
                if (is_rope) {
                    const int pos = sample ? (PAST + ((row - TOK) & 15)) : (row & (SEQ - 1));
                    const float* rp = rope + (size_t)pos * 64 + 8 * fq;
                    const f32x4 c0 = *(const f32x4*)rp, c1 = *(const f32x4*)(rp + 4), s0 = *(const f32x4*)(rp + 32), s1 = *(const f32x4*)(rp + 36);
                    const f32x4 x10 = v[0][0], x11 = v[0][1], x20 = v[1][0], x21 = v[1][1];
                    v[0][0] = x10 * c0 - x20 * s0; v[0][1] = x11 * c1 - x21 * s1;
                    v[1][0] = x10 * s0 + x20 * c0; v[1][1] = x11 * s1 + x21 * c1;
                }
#pragma unroll
                for (int bj = 0; bj < 2; ++bj) {
                    const int col = (pn & 1) * 256 + (is_rope ? (wc * 64 + bj * 32) : (bj * 128 + wc * 32)) + 8 * fq;
                    f32x4 v0 = v[bj][0], v1 = v[bj][1];
                    if (fmode) {
                        if (!sample) {
                            if (fmode == 2) { float* fo = fprompt + (size_t)row * BW + col; *(f32x4*)fo = v0; *(f32x4*)(fo + 4) = v1; }
                            else { const int s = row & (SEQ - 1); if (s >= SEQ - APAST) { float* fo = fprompt + ((size_t)(row >> 12) * APAST + (s - (SEQ - APAST))) * BW + col; *(f32x4*)fo = v0; *(f32x4*)(fo + 4) = v1; } }
                        } else if (row < TOK + STOK) {
                            const int sr = row - TOK; float* fo = fsample + (size_t)sr * BW + col; *(f32x4*)fo = v0; *(f32x4*)(fo + 4) = v1;
                        }
                    }
                    if (is_silu) {
#pragma unroll
                        for (int e = 0; e < 4; ++e) { v0[e] = v0[e] * fast_sigmoid(v0[e]); v1[e] = v1[e] * fast_sigmoid(v1[e]); }
                    }
                    v0 = v0 * scale; v1 = v1 * scale;
                    u32x4 w; w.x = cvtpk(v0[0], v0[1]); w.y = cvtpk(v0[2], v0[3]); w.z = cvtpk(v1[0], v1[1]); w.w = cvtpk(v1[2], v1[3]);
                    *(u32x4*)(slot + (size_t)row * SLD + col) = w;
                    if (fmode && sample && row < TOK + STOK) {
                        const int sr = row - TOK, sb = sr >> 4, t = sr & 15;
                        *(u32x4*)(scache + ((size_t)sb * crows + cpast + t) * SLD + col) = w;
                    }
                }
            }
    }
};
#ifndef P1_STAGGER_TICKS
#define P1_STAGGER_TICKS 0
#endif
__device__ __forceinline__ void stagger_start(int bid, unsigned ticks) {
    if (ticks && ((bid >> 3) & 1)) { const unsigned long long t0 = __builtin_amdgcn_s_memrealtime(); while (__builtin_amdgcn_s_memrealtime() - t0 < ticks) __builtin_amdgcn_s_sleep(32); }
    __syncthreads();
}
__device__ __forceinline__ void p1_phase(Frame& F, int dry = 0) {
    stagger_start(F.bid, P1_STAGGER_TICKS);
    P1Sched S{(const char*)F.out, (const char*)(F.ws + WS_WTIN), F.G, F.bid};
    P1Epi E{F.ws, F.out, (const float*)(F.ws + WS_ROPE), dry};
    pg8::gemm_phase<P1Epi, P1Sched>(F.lds, S, E);
}
#ifndef ATT_EN_MASK
#define ATT_EN_MASK 7
#endif
namespace att {
constexpr int TILE_B = 16384;
constexpr int L_K0 = 0, L_V0 = TILE_B, L_K1 = 2 * TILE_B, L_V1 = 3 * TILE_B;
constexpr int STG_LD = 132;
constexpr int L_STAGE = 0, STG_WAVE = 32 * STG_LD * 4;
constexpr int L_WSF = 8 * STG_WAVE;
constexpr int L_BIAS = L_WSF + 8 * 256;
constexpr int L_MISC = L_BIAS + 2 * 272 * 4;
static_assert(L_MISC + 64 <= LDS_BYTES, "attention LDS map");
constexpr float NEG_BIG = -1e30f;

__device__ __forceinline__ int crow(int r, int hi) { return (r & 3) + 8 * (r >> 2) + 4 * hi; }
__device__ __forceinline__ unsigned tile_off(unsigned row, unsigned ch) { return 256u * row + 16u * (ch ^ (((row & 3u) << 2) | ((row >> 2) & 3u))); }
typedef short v4i16_t __attribute__((ext_vector_type(4)));
__device__ __forceinline__ s16x4 vtr(LAS const unsigned char* p) { return __builtin_bit_cast(s16x4, __builtin_amdgcn_ds_read_tr16_b64_v4i16((LAS v4i16_t*)p)); }

struct Unit {
    const bf16_t* Q; const bf16_t* K; const bf16_t* V; bf16_t* Z;
    int t_begin, t_end;
    int nvalid;
    int kv_last;
    int qpos0;
    int head0;
};
struct Consts { const float* rel_bias; const float* subln; float lam; int dry; };

template <int MODE>
__device__ __forceinline__ void run_unit(LAS unsigned char* lds, const Unit& u, const Consts& cs) {
    constexpr int NKS = (MODE == 2) ? 8 : 4;
    constexpr int NDB = (MODE == 0) ? 2 : 4;
    constexpr float THR = 8.0f;
    int tid = threadIdx.x; asm volatile("" : "+v"(tid));
    const int lane = tid & 63, r32 = lane & 31, hi = lane >> 5;
    const int wid = __builtin_amdgcn_readfirstlane(tid >> 6);
    const int grp = (MODE == 2) ? 0 : (wid >> 2), sub = (MODE == 2) ? wid : (wid & 3);
    const int kc0 = (MODE == 2) ? 0 : 8 * grp;
    const int vc0 = (MODE == 0) ? 8 * grp : 0;
    const bool active = 32 * sub < u.nvalid;
    int wt0 = u.t_begin, wt1 = u.t_end;
    if (MODE != 2) { const int c = (u.qpos0 + 32 * sub) >> 6; wt1 = min(wt1, c + 1); if (MODE == 0) wt0 = max(wt0, c - 8); }
    if (!active) wt1 = wt0;
    LAS float* wsf = (LAS float*)(lds + L_WSF) + wid * 64;
    if (MODE == 0) { LAS float* bl = (LAS float*)(lds + L_BIAS);
        for (int i = tid; i < 2 * 257; i += NTHREADS) { const int h = i >= 257 ? 1 : 0, j = i - 257 * h; bl[h * 272 + j] = cs.rel_bias[(u.head0 + h) * 257 + j] * LOG2E; } }
    bf16x8 qr[NKS];
    { const bf16_t* qp = u.Q + (size_t)(32 * sub + r32) * SLD + ((MODE == 2) ? 0 : 64 * grp) + 8 * hi;
#pragma unroll
      for (int s = 0; s < NKS; ++s) qr[s] = *(const bf16x8*)(qp + 16 * s); }
    const int srow0 = tid >> 4, sch = tid & 15;
    const unsigned so0 = tile_off(srow0, sch), so1 = tile_off(srow0 + 32, sch);
    const bf16_t* kg = u.K + (size_t)srow0 * SLD + 8 * sch; const bf16_t* vg = u.V + (size_t)srow0 * SLD + 8 * sch;
    u32x4 kreg0, kreg1, vreg0, vreg1;
#define LOAD_TILE(t) do { const size_t o_ = (size_t)(t) * 64 * SLD; kreg0 = *(const u32x4*)(kg + o_); kreg1 = *(const u32x4*)(kg + o_ + 32 * SLD); vreg0 = *(const u32x4*)(vg + o_); vreg1 = *(const u32x4*)(vg + o_ + 32 * SLD); } while (0)
#define WRITE_TILE(kb, vb) do { *(LAS u32x4*)(lds + (kb) + so0) = kreg0; *(LAS u32x4*)(lds + (kb) + so1) = kreg1; *(LAS u32x4*)(lds + (vb) + so0) = vreg0; *(LAS u32x4*)(lds + (vb) + so1) = vreg1; } while (0)
    const unsigned xk = ((r32 & 3u) << 2) | ((r32 >> 2) & 3u);
    const unsigned kbase = 256u * r32;
    const unsigned qv = (lane & 15) >> 2, pv = lane & 3, blk = (lane >> 4) & 1;
    const unsigned vrow = 4u * hi + qv;
    f32x16 o[NDB];
#pragma unroll
    for (int c = 0; c < NDB; ++c) o[c] = f32x16{};
    float m_run = NEG_BIG, l_run = 0.f;
    const int qpos_w = u.qpos0 + 32 * sub;

    LOAD_TILE(u.t_begin);
    WRITE_TILE(L_K0, L_V0);
    __syncthreads();
    const int ntile = u.t_end - u.t_begin;
    for (int i = 0; i < ntile; ++i) {
        const int t = u.t_begin + i; const int cur = i & 1;
        const int kb = cur ? L_K1 : L_K0, vb = cur ? L_V1 : L_V0;
        if (i + 1 < ntile) LOAD_TILE(t + 1);
        if (t >= wt0 && t < wt1) {
            f32x16 p0, p1;
            if (MODE == 0) {
                const LAS float* bl = (const LAS float*)(lds + L_BIAS) + grp * 272;
                const int d0 = qpos_w - 64 * t;
                if (d0 - 63 >= 128) { const float bf = bl[256];
#pragma unroll
                    for (int r = 0; r < 16; ++r) { p0[r] = bf; p1[r] = bf; } }
                else {
#pragma unroll
                    for (int r = 0; r < 16; ++r) { const int dd = d0 + r32 - crow(r, hi);
                        p0[r] = bl[min(max(dd, -128), 128) + 128]; p1[r] = bl[min(max(dd - 32, -128), 128) + 128]; } }
            } else { p0 = f32x16{}; p1 = f32x16{}; }
#pragma unroll
            for (int s = 0; s < NKS; ++s) {
                const unsigned co = 16u * ((unsigned)(kc0 + 2 * s + hi) ^ xk);
                const bf16x8 k0 = *(const LAS bf16x8*)(lds + kb + kbase + co), k1 = *(const LAS bf16x8*)(lds + kb + 8192 + kbase + co);
                p0 = __builtin_amdgcn_mfma_f32_32x32x16_bf16(k0, qr[s], p0, 0, 0, 0);
                p1 = __builtin_amdgcn_mfma_f32_32x32x16_bf16(k1, qr[s], p1, 0, 0, 0);
            }
            if (t == u.t_end - 1 && u.kv_last < 64) {
#pragma unroll
                for (int r = 0; r < 16; ++r) { if (crow(r, hi) >= u.kv_last) p0[r] = NEG_BIG; if (32 + crow(r, hi) >= u.kv_last) p1[r] = NEG_BIG; }
            }
            float mx = fmaxf(p0[0], p1[0]);
#pragma unroll
            for (int r = 1; r < 16; ++r) mx = fmaxf(mx, fmaxf(p0[r], p1[r]));
            mx = fmaxf(mx, __shfl_xor(mx, 32));
            if (__any(mx > m_run + THR)) {
                const float mn = fmaxf(m_run, mx), f = __builtin_amdgcn_exp2f(m_run - mn);
                l_run *= f; m_run = mn;
                if (hi == 0) wsf[r32] = f;
                LDS_WAIT();
#pragma unroll
                for (int r = 0; r < 16; ++r) { const float fr_ = wsf[crow(r, hi)];
#pragma unroll
                    for (int c = 0; c < NDB; ++c) o[c][r] *= fr_; }
            }
            float ls = 0.f;
#pragma unroll
            for (int r = 0; r < 16; ++r) { p0[r] = __builtin_amdgcn_exp2f(p0[r] - m_run); p1[r] = __builtin_amdgcn_exp2f(p1[r] - m_run); ls += p0[r] + p1[r]; }
            l_run += ls;
            bf16x8 pa[4];
#pragma unroll
            for (int ks = 0; ks < 4; ++ks) { const int b8 = 8 * (ks & 1); u32x4 w;
                if (ks < 2) { w.x = cvtpk(p0[b8], p0[b8 + 1]); w.y = cvtpk(p0[b8 + 2], p0[b8 + 3]); w.z = cvtpk(p0[b8 + 4], p0[b8 + 5]); w.w = cvtpk(p0[b8 + 6], p0[b8 + 7]); }
                else { w.x = cvtpk(p1[b8], p1[b8 + 1]); w.y = cvtpk(p1[b8 + 2], p1[b8 + 3]); w.z = cvtpk(p1[b8 + 4], p1[b8 + 5]); w.w = cvtpk(p1[b8 + 6], p1[b8 + 7]); }
                pa[ks] = __builtin_bit_cast(bf16x8, w); }
#pragma unroll
            for (int c = 0; c < NDB; ++c) {
#pragma unroll
                for (int ks = 0; ks < 4; ++ks) {
                    s16x4 lo, hh;
                    { const unsigned row = 16u * ks + vrow, ch = (unsigned)(vc0 + 4 * c) + 2u * blk + (pv >> 1); lo = vtr(lds + vb + tile_off(row, ch) + 8u * (pv & 1)); }
                    { const unsigned row = 16u * ks + 8u + vrow, ch = (unsigned)(vc0 + 4 * c) + 2u * blk + (pv >> 1); hh = vtr(lds + vb + tile_off(row, ch) + 8u * (pv & 1)); }
                    const bf16x8 vf = (bf16x8){lo[0], lo[1], lo[2], lo[3], hh[0], hh[1], hh[2], hh[3]};
                    o[c] = __builtin_amdgcn_mfma_f32_32x32x16_bf16(pa[ks], vf, o[c], 0, 0, 0);
                }
            }
        }
        if (i + 1 < ntile) { if (cur) WRITE_TILE(L_K0, L_V0); else WRITE_TILE(L_K1, L_V1); }
        __syncthreads();
    }
#undef LOAD_TILE
#undef WRITE_TILE
    { float lt = l_run + __shfl_xor(l_run, 32); const float inv = active ? __builtin_amdgcn_rcpf(lt) : 0.f;
      if (hi == 0) wsf[32 + r32] = inv; LDS_WAIT(); }
    float rli[16];
#pragma unroll
    for (int r = 0; r < 16; ++r) rli[r] = wsf[32 + crow(r, hi)];
    if (MODE != 1) {
        LAS float* stg = (LAS float*)(lds + L_STAGE + wid * STG_WAVE);
#pragma unroll
        for (int c = 0; c < NDB; ++c)
#pragma unroll
            for (int r = 0; r < 16; ++r) stg[crow(r, hi) * STG_LD + 32 * c + r32] = o[c][r] * rli[r];
        LDS_WAIT(); asm volatile("" ::: "memory");
        constexpr int NC = 32 * NDB, HC = NC / 2;
        const int row = lane >> 1, half = lane & 1;
        if (32 * sub + row < u.nvalid) {
            bf16_t* zp = u.Z + (size_t)(32 * sub + row) * SLD + ((MODE == 0) ? 64 * grp : 0) + half * HC;
            const LAS float* sp = stg + row * STG_LD + half * HC;
#pragma unroll
            for (int j = 0; j < HC / 8; ++j) {
                const f32x4 a = *(const LAS f32x4*)(sp + 8 * j), b = *(const LAS f32x4*)(sp + 8 * j + 4);
                const u32x4 z = *(const u32x4*)(zp + 8 * j);
                u32x4 w; w.x = cvtpk(a[0] * bf_lo(z.x), a[1] * bf_hi(z.x)); w.y = cvtpk(a[2] * bf_lo(z.y), a[3] * bf_hi(z.y));
                w.z = cvtpk(b[0] * bf_lo(z.z), b[1] * bf_hi(z.z)); w.w = cvtpk(b[2] * bf_lo(z.w), b[3] * bf_hi(z.w));
                if (!((ATT_EN_MASK >> MODE) & 1)) w = (u32x4){0u, 0u, 0u, 0u};
                if (!cs.dry) *(u32x4*)(zp + 8 * j) = w;
            }
        }
        LDS_WAIT();
        __syncthreads();
    } else {
        LAS float* stg = (LAS float*)(lds + L_STAGE + sub * STG_WAVE);
        if (grp == 1) {
#pragma unroll
            for (int c = 0; c < NDB; ++c)
#pragma unroll
                for (int r = 0; r < 16; ++r) stg[crow(r, hi) * STG_LD + 32 * c + r32] = o[c][r] * rli[r];
        }
        LDS_WAIT(); __syncthreads();
        if (grp == 0) {
            const float lam = cs.lam;
#pragma unroll
            for (int c = 0; c < NDB; ++c)
#pragma unroll
                for (int r = 0; r < 16; ++r) { LAS float* p = stg + crow(r, hi) * STG_LD + 32 * c + r32; *p = o[c][r] * rli[r] - lam * (*p); }
        }
        LDS_WAIT(); __syncthreads();
        {
            const int urow = 16 * wid + (lane >> 2), quarter = lane & 3;
            const LAS float* sp = (const LAS float*)(lds + L_STAGE + (urow >> 5) * STG_WAVE) + (urow & 31) * STG_LD + 32 * quarter;
            f32x4 vv[8]; float ss = 0.f;
#pragma unroll
            for (int j = 0; j < 8; ++j) { vv[j] = *(const LAS f32x4*)(sp + 4 * j); ss += (vv[j][0] * vv[j][0] + vv[j][1] * vv[j][1]) + (vv[j][2] * vv[j][2] + vv[j][3] * vv[j][3]); }
            ss += __shfl_xor(ss, 1); ss += __shfl_xor(ss, 2);
            const float rn = (1.0f - LAM_INIT) / sqrtf(ss * (1.0f / 128.0f) + RMS_EPS);
            if (urow < u.nvalid) {
                bf16_t* zp = u.Z + (size_t)urow * SLD + 32 * quarter; const float* gp = cs.subln + 32 * quarter;
#pragma unroll
                for (int j = 0; j < 4; ++j) {
                    const f32x4 a = vv[2 * j], b = vv[2 * j + 1]; const f32x4 g0 = *(const f32x4*)(gp + 8 * j), g1 = *(const f32x4*)(gp + 8 * j + 4);
                    const u32x4 z = *(const u32x4*)(zp + 8 * j);
                    u32x4 w; w.x = cvtpk(a[0] * rn * g0[0] * bf_lo(z.x), a[1] * rn * g0[1] * bf_hi(z.x)); w.y = cvtpk(a[2] * rn * g0[2] * bf_lo(z.y), a[3] * rn * g0[3] * bf_hi(z.y));
                    w.z = cvtpk(b[0] * rn * g1[0] * bf_lo(z.z), b[1] * rn * g1[1] * bf_hi(z.z)); w.w = cvtpk(b[2] * rn * g1[2] * bf_lo(z.w), b[3] * rn * g1[3] * bf_hi(z.w));
                    if (!((ATT_EN_MASK >> 1) & 1)) w = (u32x4){0u, 0u, 0u, 0u};
                    if (!cs.dry) *(u32x4*)(zp + 8 * j) = w;
                }
            }
        }
        LDS_WAIT();
        __syncthreads();
    }
}

constexpr int Q_SB = 4, Q_B = 256, Q_A = 256, Q_M = 128, Q_SA = 4, Q_SM = 4;
constexpr int Q_LEN = Q_SB + Q_B + Q_A + Q_M + Q_SA + Q_SM;
__device__ __forceinline__ int decode_unit(unsigned char* ws, int q, int idx, Unit& u) {
    auto S = [&](int s) { return slot_ptr(ws, s); };
    u.kv_last = 64; u.head0 = 0;
    if (idx < Q_SB) { const int sp = idx * 8 + q, b = sp >> 2, h = sp & 3; const size_t qo = (size_t)(TOK + STEP * b) * SLD + 128 * h, ko = (size_t)b * SKB_ROWS * SLD + 128 * h;
        u.Q = S(S_BQ) + qo; u.Z = S(S_BZ) + qo; u.K = (const bf16_t*)(ws + WS_SKVB) + ko; u.V = (const bf16_t*)(ws + WS_SKVB) + BW + ko;
        u.t_begin = 0; u.t_end = SKB_ROWS / 64; u.nvalid = STEP; u.kv_last = STEP; u.qpos0 = PAST; return 1; }
    idx -= Q_SB;
    if (idx < Q_B) { const int pair = (idx >> 5) * 8 + q, qt = 31 - (idx & 31), b = pair >> 2, h = pair & 3; const size_t ko = (size_t)b * SEQ * SLD + 128 * h, qo = ko + (size_t)(128 * qt) * SLD;
        u.Q = S(S_BQ) + qo; u.Z = S(S_BZ) + qo; u.K = S(S_BK) + ko; u.V = S(S_BV) + ko; u.t_begin = 0; u.t_end = 2 * qt + 2; u.nvalid = 128; u.qpos0 = 128 * qt; return 1; }
    idx -= Q_B;
    if (idx < Q_A) { const int pair = (idx >> 5) * 8 + q, cp = idx & 31, b = pair >> 2, hp = pair & 3; const size_t ko = (size_t)b * SEQ * SLD + 128 * hp, qo = ko + (size_t)(128 * cp) * SLD;
        u.Q = S(S_AQ) + qo; u.Z = S(S_AZ) + qo; u.K = S(S_AK) + ko; u.V = S(S_AV) + ko; u.t_begin = max(0, 2 * cp - 8); u.t_end = 2 * cp + 2; u.nvalid = 128; u.qpos0 = 128 * cp; u.head0 = 2 * hp; return 0; }
    idx -= Q_A;
    if (idx < Q_M) { const int pair = (idx >> 4) * 8 + q, qt = idx & 15, b = pair >> 2, h = pair & 3; const size_t qo = (size_t)(b * SEQ + 256 * qt) * SLD + 128 * h, ko = (size_t)b * NMEM * SLD + 128 * h;
        u.Q = S(S_MQ) + qo; u.Z = S(S_MZ) + qo; u.K = (const bf16_t*)(ws + WS_MKV) + ko; u.V = (const bf16_t*)(ws + WS_MKV) + BW + ko; u.t_begin = 0; u.t_end = 4; u.nvalid = 256; u.qpos0 = 0; return 2; }
    idx -= Q_M;
    if (idx < Q_SA) { const int sp = idx * 8 + q, b = sp >> 2, hp = sp & 3; const size_t qo = (size_t)(TOK + STEP * b) * SLD + 128 * hp, ko = (size_t)b * SKA_ROWS * SLD + 128 * hp;
        u.Q = S(S_AQ) + qo; u.Z = S(S_AZ) + qo; u.K = (const bf16_t*)(ws + WS_SKVA) + ko; u.V = (const bf16_t*)(ws + WS_SKVA) + BW + ko; u.t_begin = 0; u.t_end = SKA_ROWS / 64; u.nvalid = STEP; u.kv_last = STEP; u.qpos0 = APAST; u.head0 = 2 * hp; return 0; }
    idx -= Q_SA;
    { const int sp = idx * 8 + q, b = sp >> 2, h = sp & 3; const size_t qo = (size_t)(TOK + STEP * b) * SLD + 128 * h, ko = (size_t)b * NMEM * SLD + 128 * h;
        u.Q = S(S_MQ) + qo; u.Z = S(S_MZ) + qo; u.K = (const bf16_t*)(ws + WS_SMKV) + ko; u.V = (const bf16_t*)(ws + WS_SMKV) + BW + ko; u.t_begin = 0; u.t_end = 4; u.nvalid = STEP; u.qpos0 = 0; return 2; }
}
__device__ __forceinline__ unsigned xcc_id() { return (unsigned)__builtin_amdgcn_s_getreg((3 << 11) | 20) & 0x7u; }
}

__device__ __forceinline__ void p2_phase(Frame& F, int dry = 0) {
    using namespace att;
    unsigned* ctl = (unsigned*)(F.ws + WS_CTL);
    volatile LAS int* misc = (volatile LAS int*)(F.lds + L_MISC);
    Consts cs; cs.rel_bias = F.in[I_RELB]; cs.subln = F.in[I_SUBLN]; cs.lam = ((const float*)ctl)[CW_LAM]; cs.dry = dry;
    const int qbase = CW_QUEUE + (dry ? 1024 : 0);
    const int myq = (int)xcc_id();
    int qoff = 0;
#define P2_FETCH(dst) do { int r_ = -1; while (qoff < 8) { const int q_ = (myq + qoff) & 7; const unsigned idx_ = __hip_atomic_fetch_add(ctl + qbase + 64 * q_, 1u, __ATOMIC_RELAXED, __HIP_MEMORY_SCOPE_AGENT); \
        if (idx_ < (unsigned)Q_LEN) { r_ = (q_ << 16) | (int)idx_; break; } ++qoff; } (dst) = r_; } while (0)
    if (F.tid == 0) P2_FETCH(misc[0]);
    __syncthreads();
    for (;;) {
        const int code = misc[0];
        __syncthreads();
        if (code < 0) break;
        if (F.tid == 0) P2_FETCH(misc[0]);
        Unit u; const int mode = decode_unit(F.ws, code >> 16, code & 0xffff, u);
        if (mode == 0) run_unit<0>(F.lds, u, cs); else if (mode == 1) run_unit<1>(F.lds, u, cs); else run_unit<2>(F.lds, u, cs);
        __syncthreads();
    }
}
constexpr int P3_TILES = (TOK / 256) * 4 + 4;
struct P3Sched {
    const char* H; const char* WT; const char* WTBR; unsigned char* ws; int G, c;
    __device__ __forceinline__ bool next(int i, pg8::GUnit& u) const {
        const int tu = i / 6, j = i - 6 * tu; const int L = tu * G + c; if (L >= P3_TILES) return false;
        int pm, pn; if (L < 1024) pg8::tile_order(L, TOK / 256, 4, pm, pn); else { pm = TOK / 256; pn = L - 1024; }
        u.pm = pm; u.pn = pn; u.kind = j;
        if (j < 3) { u.a = H + (size_t)pm * 256 * (DM * 2); u.b = WT + (size_t)(NPROJ + 1024 * j + 256 * pn) * (DM * 2); u.nt = DM / 64; }
        else { const int b = j - 3; const int s = (b == 0) ? S_AZ : (b == 1 ? S_BZ : S_MZ);
            u.a = (const char*)(slot_ptr(ws, s) + (size_t)pm * 256 * SLD); u.b = WTBR + ((size_t)b * DM + 256 * pn) * (SLD * 2); u.nt = BW / 64; }
        return true;
    }
};
struct P3Epi {
    unsigned char* gst; bf16_t* mixed;
    __device__ __forceinline__ void operator()(f32x4 (&acc)[2][2][4][2], const pg8::GUnit& u, int wr, int wc, int fr, int fq) const {
        const int kind = u.kind; const unsigned toff = threadIdx.x * 16u;
        const unsigned char* pn_ = gst + (size_t)(kind >= 3 ? kind - 3 : 0) * 131072 + toff;
        const unsigned char* pd_ = gst + (size_t)(kind == 3 || kind == 4 ? kind - 2 : 0) * 131072 + toff;
        unsigned char* dst = gst + (size_t)(kind < 3 ? kind : 0) * 131072 + toff;
        bf16_t* mp = mixed + (size_t)(u.pm * 256 + wr * 64 + fr) * DM + u.pn * 256 + wc * 32 + 8 * fq;
#pragma unroll
        for (int ai = 0; ai < 2; ++ai) {
#pragma unroll
            for (int m = 0; m < 4; ++m) {
#pragma unroll
                for (int bj = 0; bj < 2; ++bj) {
                    const f32x4 v0 = acc[ai][bj][m][0], v1 = acc[ai][bj][m][1];
                    f32x4 m0 = (f32x4){0.f, 0.f, 0.f, 0.f}, m1 = (f32x4){0.f, 0.f, 0.f, 0.f};
                    if (kind < 3) {
                        f32x4 s0, s1;
#pragma unroll
                        for (int e = 0; e < 4; ++e) { s0[e] = fmaxf(fast_sigmoid(v0[e]), 1e-6f); s1[e] = fmaxf(fast_sigmoid(v1[e]), 1e-6f); }
                        u32x4 w; w.x = cvtpk(s0[0], s0[1]); w.y = cvtpk(s0[2], s0[3]); w.z = cvtpk(s1[0], s1[1]); w.w = cvtpk(s1[2], s1[3]);
                        *(u32x4*)dst = w;
                    } else if (kind < 5) {
                        const u32x4 gn = *(const u32x4*)pn_, gd = *(const u32x4*)pd_;
                        m0[0] = bf_lo(gn.x) * __builtin_amdgcn_rcpf(bf_lo(gd.x)); m0[1] = bf_hi(gn.x) * __builtin_amdgcn_rcpf(bf_hi(gd.x));
                        m0[2] = bf_lo(gn.y) * __builtin_amdgcn_rcpf(bf_lo(gd.y)); m0[3] = bf_hi(gn.y) * __builtin_amdgcn_rcpf(bf_hi(gd.y));
                        m1[0] = bf_lo(gn.z) * __builtin_amdgcn_rcpf(bf_lo(gd.z)); m1[1] = bf_hi(gn.z) * __builtin_amdgcn_rcpf(bf_hi(gd.z));
                        m1[2] = bf_lo(gn.w) * __builtin_amdgcn_rcpf(bf_lo(gd.w)); m1[3] = bf_hi(gn.w) * __builtin_amdgcn_rcpf(bf_hi(gd.w));
                    } else {
                        const u32x4 g = *(const u32x4*)pn_;
                        u32x4 w; w.x = cvtpk(v0[0] * bf_lo(g.x), v0[1] * bf_hi(g.x)); w.y = cvtpk(v0[2] * bf_lo(g.y), v0[3] * bf_hi(g.y));
                        w.z = cvtpk(v1[0] * bf_lo(g.z), v1[1] * bf_hi(g.z)); w.w = cvtpk(v1[2] * bf_lo(g.w), v1[3] * bf_hi(g.w));
                        *(u32x4*)(mp + bj * 128) = w;
                    }
                    acc[ai][bj][m][0] = v0 * m0; acc[ai][bj][m][1] = v1 * m1;
                    asm volatile("" : "+v"(acc[ai][bj][m][0]), "+v"(acc[ai][bj][m][1]));
                    pn_ += 8192; pd_ += 8192; dst += 8192;
                    asm volatile("" : "+v"(pn_), "+v"(pd_), "+v"(dst));
                }
                mp += 16 * DM;
                asm volatile("" : "+v"(mp) :: "memory");
            }
            mp += 64 * DM;
        }
    }
};
__device__ __forceinline__ void p3_phase(Frame& F) {
    P3Sched S{(const char*)F.out, (const char*)(F.ws + WS_WTIN), (const char*)(F.ws + WS_WTBR), F.ws, F.G, F.bid};
    P3Epi E{F.ws + WS_GSTASH + (size_t)F.bid * 393216, (bf16_t*)(F.ws + WS_MIXED)};
    pg8::gemm_phase<P3Epi, P3Sched>(F.lds, S, E);
}

constexpr int P4_TILES = (TOK / 256) * 4 + 4;
struct P4Sched {
    const char* A; const char* WT; int G, c;
    __device__ __forceinline__ bool next(int i, pg8::GUnit& u) const {
        const int L = i * G + c; if (L >= P4_TILES) return false;
        int pm, pn; if (L < 1024) pg8::tile_order(L, TOK / 256, 4, pm, pn); else { pm = TOK / 256; pn = L - 1024; }
        u.pm = pm; u.pn = pn; u.kind = 0; u.a = A + (size_t)pm * 256 * (DM * 2); u.b = WT + (size_t)(256 * pn) * (DM * 2); u.nt = DM / 64;
        return true;
    }
};
struct P4Epi {
    const float* xp; const float* xs; float* out; float* rowsq;
    __device__ __forceinline__ void operator()(f32x4 (&acc)[2][2][4][2], const pg8::GUnit& u, int wr, int wc, int fr, int fq) const {
        const bool sample = (u.pm == TOK / 256);
#pragma unroll
        for (int ai = 0; ai < 2; ++ai)
#pragma unroll
            for (int m = 0; m < 4; ++m) {
                const int row = u.pm * 256 + ai * 128 + wr * 64 + m * 16 + fr;
                const bool valid = !sample || row < TOK + STOK;
                const float* xr = sample ? xs + (size_t)(valid ? row - TOK : 0) * DM : xp + (size_t)row * DM;
                float* orow = sample ? out + O_YS + (size_t)(valid ? row - TOK : 0) * DM : out + O_Y + (size_t)row * DM;
                float ss = 0.f;
#pragma unroll
                for (int bj = 0; bj < 2; ++bj) {
                    const int col = u.pn * 256 + bj * 128 + wc * 32 + 8 * fq;
                    const f32x4 x0 = *(const f32x4*)(xr + col), x1 = *(const f32x4*)(xr + col + 4);
                    const f32x4 h0 = acc[ai][bj][m][0] + x0, h1 = acc[ai][bj][m][1] + x1;
                    ss += (h0[0] * h0[0] + h0[1] * h0[1]) + (h0[2] * h0[2] + h0[3] * h0[3]) + (h1[0] * h1[0] + h1[1] * h1[1]) + (h1[2] * h1[2] + h1[3] * h1[3]);
                    if (valid) { *(f32x4*)(orow + col) = h0; *(f32x4*)(orow + col + 4) = h1; }
                    acc[ai][bj][m][0] = (f32x4){0.f, 0.f, 0.f, 0.f}; acc[ai][bj][m][1] = (f32x4){0.f, 0.f, 0.f, 0.f};
                }
                ss += __shfl_xor(ss, 16); ss += __shfl_xor(ss, 32);
                if (fq == 0) rowsq[(size_t)row * 16 + u.pn * 4 + wc] = ss;
                asm volatile("" ::: "memory");
            }
    }
};
__device__ __forceinline__ void p4_phase(Frame& F) {
    P4Sched S{(const char*)(F.ws + WS_MIXED), (const char*)(F.ws + WS_WTOUT), F.G, F.bid};
    P4Epi E{F.in[I_XP], F.in[I_XS], F.out, (float*)(F.ws + WS_ROWSQ)};
    pg8::gemm_phase<P4Epi, P4Sched>(F.lds, S, E);
}

__device__ __forceinline__ void p5_phase(Frame& F, int dry = 0) {
    const int gw = F.bid * NWAVES + F.wave, NGW = F.G * NWAVES, lane = F.lane;
    const float* rowsq = (const float*)(F.ws + WS_ROWSQ);
    const f32x4* gr = (const f32x4*)F.in[I_NORM_F] + lane;
    f32x4 g[4];
#pragma unroll
    for (int j = 0; j < 4; ++j) g[j] = gr[64 * j];
    for (int m = gw; m < TOK + STOK; m += NGW) {
        float* orow = m < TOK ? F.out + O_Y + (size_t)m * DM : F.out + O_YS + (size_t)(m - TOK) * DM;
        const float part = (lane < 16) ? rowsq[(size_t)m * 16 + lane] : 0.f;
        const float r = 1.0f / sqrtf(wave_sum(part) * (1.f / DM) + RMS_EPS);
        f32x4* o = (f32x4*)orow + lane;
#pragma unroll
        for (int j = 0; j < 4; ++j) { const f32x4 v = o[64 * j] * r * g[j]; if (!dry) o[64 * j] = v; else asm volatile("" :: "v"(v)); }
    }
}
#ifndef MK_N_LAUNCHES
#define MK_N_LAUNCHES 1
#endif
constexpr int N_PHASES = 6;
__global__ void __launch_bounds__(NTHREADS, 2) mk_fwd(Args args) {
    extern __shared__ __attribute__((aligned(16))) unsigned char lds_raw[];
    Frame F;
    F.lds = (LAS unsigned char*)lds_raw;
    F.tid = threadIdx.x; F.lane = F.tid & 63; F.wave = __builtin_amdgcn_readfirstlane(F.tid >> 6);
    F.G = gridDim.x; F.bid = blockIdx.x;
    F.in = args.in; F.out = args.out; F.ws = args.ws;
    const int lo = args.ph_lo, hi = args.ph_hi;
#define IN(k) (lo <= (k) && (k) < hi)
#ifndef USE_CG_SYNC
#define USE_CG_SYNC 0
#endif
#if MK_N_LAUNCHES != 1
#define GRID_SYNC() do {} while (0)
#elif USE_CG_SYNC
#define GRID_SYNC() cg::this_grid().sync()
#else
    volatile LAS unsigned* barst = (volatile LAS unsigned*)(F.lds + L_BARST);
    if (F.tid < 2) barst[F.tid] = 0u;
    __syncthreads();
    const XcdBarrier bar = xcd_barrier_post((unsigned*)(args.ws + WS_CTL) + CW_BAR, barst);
#define GRID_SYNC() xcd_barrier(bar)
#endif
#ifndef REPEAT_PHASE
#define REPEAT_PHASE -1
#endif
    if (REPEAT_PHASE == 0) { p0_prologue(F); GRID_SYNC(); }
    if (IN(0)) { p0_prologue(F); if (IN(1)) GRID_SYNC(); }
    if (REPEAT_PHASE == 1) { p1_phase(F); GRID_SYNC(); }
    if (REPEAT_PHASE == 11) { p1_phase(F, 1); GRID_SYNC(); }
    if (IN(1)) { p1_phase(F); if (IN(2)) GRID_SYNC(); }
    if (REPEAT_PHASE == 2) { p2_phase(F, 1); GRID_SYNC(); }
    if (IN(2)) { p2_phase(F); if (IN(3)) GRID_SYNC(); }
    if (REPEAT_PHASE == 3) { p3_phase(F); GRID_SYNC(); }
    if (IN(3)) { p3_phase(F); if (IN(4)) GRID_SYNC(); }
    if (REPEAT_PHASE == 4) { p4_phase(F); GRID_SYNC(); }
    if (IN(4)) { p4_phase(F); if (IN(5)) GRID_SYNC(); }
    if (REPEAT_PHASE == 5) { p5_phase(F, 1); GRID_SYNC(); }
    if (IN(5)) { p5_phase(F); }
#undef IN
}

extern "C" void kernel_launch(void* const* d_in, const int* in_sizes, int n_in, void* d_out, int out_size, void* d_ws, size_t ws_size, hipStream_t stream) {
    static int grid = 0;
    if (grid == 0) {
        if (n_in != 24 || out_size != (int)O_TOTAL || ws_size < WS_END) { fprintf(stderr, "kernel_launch: unexpected problem (n_in %d, out %d, ws %zu)\n", n_in, out_size, ws_size); grid = -1; return; }
        int dev = 0, cus = 0, per_cu = 0;
        if (hipGetDevice(&dev) != hipSuccess || hipDeviceGetAttribute(&cus, hipDeviceAttributeMultiprocessorCount, dev) != hipSuccess) { grid = -1; return; }
        if (hipFuncSetAttribute((const void*)mk_fwd, hipFuncAttributeMaxDynamicSharedMemorySize, LDS_BYTES) != hipSuccess) { fprintf(stderr, "kernel_launch: hipFuncSetAttribute failed\n"); grid = -1; return; }
        if (hipOccupancyMaxActiveBlocksPerMultiprocessor(&per_cu, (const void*)mk_fwd, NTHREADS, LDS_BYTES) != hipSuccess || per_cu < 1) { fprintf(stderr, "kernel_launch: occupancy query says %d\n", per_cu); per_cu = 1; }
        (void)hipGetLastError();
        grid = cus;
    }
    if (grid < 0) return;
    Args a{};
    for (int i = 0; i < 24; ++i) a.in[i] = (const float*)d_in[i];
    a.out = (float*)d_out; a.ws = (unsigned char*)d_ws;
#if MK_N_LAUNCHES == 1
    a.ph_lo = 0; a.ph_hi = N_PHASES;
#if USE_CG_SYNC
    void* kargs[] = {&a};
    hipError_t e = hipLaunchCooperativeKernel((const void*)mk_fwd, dim3(grid), dim3(NTHREADS), kargs, LDS_BYTES, stream);
    if (e != hipSuccess) fprintf(stderr, "kernel_launch: cooperative launch failed: %s (grid %d)\n", hipGetErrorString(e), grid);
#else
    if (hipMemsetAsync((char*)d_ws + WS_CTL, 0, CTL_ZERO_BYTES, stream) != hipSuccess) { fprintf(stderr, "kernel_launch: memset failed\n"); return; }
    hipLaunchKernelGGL(mk_fwd, dim3(grid), dim3(NTHREADS), LDS_BYTES, stream, a);
#endif
#else
    for (int p = 0; p < N_PHASES; ++p) { a.ph_lo = p; a.ph_hi = p + 1; hipLaunchKernelGGL(mk_fwd, dim3(grid), dim3(NTHREADS), LDS_BYTES, stream, a); }
#endif
}
```

```cpp
#include <hip/hip_runtime.h>
#include <hip/hip_cooperative_groups.h>
#include <cstdint>
#include <cstdio>
namespace cg = cooperative_groups;

#define LAS __attribute__((address_space(3)))
#define GAS __attribute__((address_space(1)))
typedef unsigned short bf16_t;
typedef short bf16x8 __attribute__((ext_vector_type(8)));
typedef short s16x4 __attribute__((ext_vector_type(4)));
typedef float f32x2 __attribute__((ext_vector_type(2)));
typedef float f32x4 __attribute__((ext_vector_type(4)));
typedef float f32x16 __attribute__((ext_vector_type(16)));
typedef unsigned u32x2 __attribute__((ext_vector_type(2)));
typedef unsigned u32x4 __attribute__((ext_vector_type(4)));
typedef __bf16 bf16x2_t __attribute__((ext_vector_type(2)));

constexpr int DM = 1024;
constexpr int NBATCH = 16, SEQ = 4096, TOK = NBATCH * SEQ;
constexpr int SBATCH = 8, STEP = 16, STOK = SBATCH * STEP;
constexpr int PAST = 4096, APAST = 512;
constexpr int ROWS = TOK + 256;
constexpr int NMEM = 256, MEMROWS = NBATCH * NMEM;
constexpr int BW = 512;
constexpr int NPROJ = 5120;
constexpr float RMS_EPS = 1e-6f;
constexpr float LOG2E = 1.4426950408889634f;
constexpr float LAM_INIT = 0.2f;
constexpr int SKA_ROWS = 576, SKB_ROWS = 4160;

constexpr size_t O_Y = 0, O_YS = 67108864, O_AK = O_YS + 131072, O_AV = O_AK + 4194304, O_BK = O_AV + 4194304, O_BV = O_BK + 33554432,
                 O_MK = O_BV + 33554432, O_MV = O_MK + 2097152, O_SAK = O_MV + 2097152, O_SAV = O_SAK + 65536, O_SBK = O_SAV + 65536, O_SBV = O_SBK + 65536,
                 O_TOTAL = O_SBV + 65536;
static_assert(O_TOTAL == 147193856, "d_out size");

constexpr size_t MiB = 1u << 20;
constexpr size_t WS_CTL = 0;
constexpr size_t WS_WTIN = 1 * MiB;
constexpr size_t WS_WTBR = 19 * MiB;
constexpr size_t WS_WTOUT = 25 * MiB;
constexpr size_t WS_ROPE = 27 * MiB;
constexpr size_t WS_ROWSQ = 29 * MiB;
constexpr int SLD = 1024;
constexpr size_t WS_MKV = 34 * MiB;
constexpr size_t WS_SKVA = 42 * MiB;
constexpr size_t WS_SMKV = 51 * MiB;
constexpr size_t WS_SKVB = 55 * MiB;
constexpr size_t WS_SLOT0 = 120 * MiB, PAIR_BYTES = (size_t)ROWS * SLD * 2;
enum Slot { S_AK = 0, S_AV, S_BQ, S_BK, S_AQ, S_BV, S_MQ, S_AZ, S_BZ, S_MZ, S_N };
constexpr size_t WS_MIXED = WS_SLOT0;
constexpr size_t WS_GSTASH = WS_SLOT0 + PAIR_BYTES;
constexpr size_t WS_END = WS_SLOT0 + (S_N / 2) * PAIR_BYTES;
static_assert(WS_END <= 1024 * MiB, "d_ws map");
constexpr size_t H_BYTES = (size_t)(ROWS + MEMROWS) * DM * 2;
static_assert(H_BYTES <= (size_t)O_YS * 4, "H fits the y_prompt region");

constexpr int CW_LAM = 16;
constexpr int CW_QUEUE = 64;
constexpr int CW_BAR = 4096;
constexpr size_t CTL_ZERO_BYTES = 65536;

constexpr int LDS_BYTES = 163840;
constexpr int L_BARST = LDS_BYTES - 64;
constexpr int NWAVES = 8, NTHREADS = 512;

__device__ __forceinline__ unsigned cvtpk(float lo, float hi) { f32x2 v = {lo, hi}; bf16x2_t b = __builtin_convertvector(v, bf16x2_t); return __builtin_bit_cast(unsigned, b); }
__device__ __forceinline__ float bf_lo(unsigned u) { return __uint_as_float(u << 16); }
__device__ __forceinline__ float bf_hi(unsigned u) { return __uint_as_float(u & 0xffff0000u); }
__device__ __forceinline__ float wave_sum(float v) {
#pragma unroll
    for (int o = 1; o < 64; o <<= 1) v += __shfl_xor(v, o);
    return v;
}
__device__ __forceinline__ float fast_sigmoid(float x) { return __builtin_amdgcn_rcpf(1.0f + __builtin_amdgcn_exp2f(-x * LOG2E)); }
#define LDS_WAIT() asm volatile("s_waitcnt lgkmcnt(0)" ::: "memory")
#define VM_WAIT() asm volatile("s_waitcnt vmcnt(0)" ::: "memory")
namespace pg8 {
constexpr int BM = 256, BK = 64, HALF = 128, HTB = HALF * BK * 2  , STAGE_BYTES = 8 * HTB;
__host__ __device__ __forceinline__ int lds_byte(int r, int c) { const int st = (r >> 4) * 2 + (c >> 5), rr = r & 15, cc = c & 31, ob = rr * 64 + cc * 2; return st * 1024 + (ob ^ (((ob >> 9) & 1) << 5)); }
__host__ __device__ __forceinline__ void stage_rc(int b, int& R, int& C) { const int st = b / 1024, sb = b % 1024, swz = sb ^ (((sb >> 9) & 1) << 5); R = (st >> 1) * 16 + swz / 64; C = (st & 1) * 32 + (swz % 64) / 2; }
__host__ __device__ __forceinline__ int perm32(int rho) { const int n = rho >> 4, i = rho & 15; return 8 * (i >> 2) + 4 * n + (i & 3); }

constexpr unsigned LD = 2048;
struct GUnit { const char* a; const char* b; int nt; int kind; int pm, pn; };

template <class Epi, class Sched>
__device__ __forceinline__ void gemm_phase(LAS unsigned char* lds, const Sched& S, const Epi& E) {
    const int tid = threadIdx.x, wid = __builtin_amdgcn_readfirstlane(tid >> 6), lane = tid & 63, wr = wid >> 2, wc = wid & 3, fr = lane & 15, fq = lane >> 4;
    unsigned RA[2], RB[2], C2[2];
#pragma unroll
    for (int i = 0; i < 2; ++i) { int R, C; stage_rc(tid * 16 + i * 8192, R, C); RA[i] = (unsigned)R; RB[i] = (unsigned)((R & ~31) + perm32(R & 31)); C2[i] = (unsigned)(C * 2); }
    const size_t kstep = (size_t)(BK * 2);
    const unsigned ldsw = (unsigned)wid * 1024u;
    const int aoff = lds_byte(wr * 64 + fr, fq * 8), boff = lds_byte(wc * 32 + fr, fq * 8);
#define PG8_SA(b, h) (((b) * 2 + (h)) * HTB)
#define PG8_SB(b, h) ((4 + (b) * 2 + (h)) * HTB)
#define PG8_STAGE(bufoff, gbase, RV) do { _Pragma("unroll") for (int _i = 0; _i < 2; ++_i) \
        __builtin_amdgcn_global_load_lds((const unsigned*)((const char*)(gbase) + (size_t)(RV[_i] * LD + C2[_i])), (LAS unsigned*)(lds + (bufoff) + ldsw + _i * 8192), 16, 0, 0); } while (0)
#define PG8_LDA(dst, b, h) do { _Pragma("unroll") for (int m = 0; m < 4; ++m) _Pragma("unroll") for (int k = 0; k < 2; ++k) dst[m][k] = *(const LAS bf16x8*)(lds + PG8_SA(b, h) + aoff + m * 2048 + k * 1024); } while (0)
#define PG8_LDB(dst, b, h) do { _Pragma("unroll") for (int n = 0; n < 2; ++n) _Pragma("unroll") for (int k = 0; k < 2; ++k) dst[n][k] = *(const LAS bf16x8*)(lds + PG8_SB(b, h) + boff + n * 2048 + k * 1024); } while (0)
#define PG8_MMA(ai, bj, At, Bt) do { __builtin_amdgcn_s_setprio(1); _Pragma("unroll") for (int m = 0; m < 4; ++m) _Pragma("unroll") for (int n = 0; n < 2; ++n) _Pragma("unroll") for (int k = 0; k < 2; ++k) \
        acc[ai][bj][m][n] = __builtin_amdgcn_mfma_f32_16x16x32_bf16(Bt[n][k], At[m][k], acc[ai][bj][m][n], 0, 0, 0); __builtin_amdgcn_s_setprio(0); } while (0)
#define PG8_WAIT_V(n) asm volatile("s_waitcnt vmcnt(" #n ")" ::: "memory")
#define PG8_WAIT_L(n) asm volatile("s_waitcnt lgkmcnt(" #n ")" ::: "memory")
#define PG8_BAR __builtin_amdgcn_s_barrier()
#define PG8_SCHED __builtin_amdgcn_sched_barrier(0)
    GUnit cur, nxt; int ui = 0;
    if (!S.next(0, cur)) return;
    f32x4 acc[2][2][4][2];
#pragma unroll
    for (int a = 0; a < 2; ++a)
#pragma unroll
        for (int b = 0; b < 2; ++b)
#pragma unroll
            for (int m = 0; m < 4; ++m)
#pragma unroll
                for (int n = 0; n < 2; ++n) acc[a][b][m][n] = (f32x4){0.f, 0.f, 0.f, 0.f};
    bf16x8 At[4][2], B0[2][2], B1[2][2];
    const char* cA = cur.a; const char* cB = cur.b;
    {
        constexpr size_t hA = (size_t)HALF * LD, hB = (size_t)HALF * LD;
        PG8_STAGE(PG8_SB(0, 0), cB, RB); PG8_STAGE(PG8_SB(0, 1), cB + hB, RB); PG8_STAGE(PG8_SA(0, 0), cA, RA); PG8_STAGE(PG8_SA(0, 1), cA + hA, RA);
        if (wr == 1) PG8_BAR;
        PG8_WAIT_V(2); PG8_BAR;
        PG8_STAGE(PG8_SB(1, 0), cB + kstep, RB); PG8_STAGE(PG8_SA(1, 0), cA + kstep, RA); PG8_STAGE(PG8_SB(1, 1), cB + hB + kstep, RB);
        PG8_WAIT_V(6); PG8_BAR;
    }
    for (;;) {
        const bool has_next = S.next(ui + 1, nxt);
        const char* nA = has_next ? nxt.a : cA; const char* nB = has_next ? nxt.b : cB;
        const int nt = cur.nt;
        constexpr size_t hA = (size_t)HALF * LD, hB = (size_t)HALF * LD, hA2 = hA, hB2 = hB;
        for (int t = 0; t < nt; t += 2) {
            const bool last = (t == nt - 2);
            const char* a1 = cA + (size_t)(t + 1) * kstep;
            const char* a2 = last ? nA : cA + (size_t)(t + 2) * kstep; const char* b2 = last ? nB : cB + (size_t)(t + 2) * kstep;
            const char* a3 = a2 + kstep; const char* b3 = b2 + kstep;
            PG8_LDB(B0, 0, 0); PG8_LDB(B1, 0, 1); PG8_SCHED; PG8_LDA(At, 0, 0); PG8_STAGE(PG8_SA(1, 1), a1 + hA, RA);
            PG8_WAIT_V(8); PG8_WAIT_L(0); PG8_BAR; PG8_MMA(0, 0, At, B0); PG8_MMA(0, 1, At, B1); PG8_BAR; PG8_SCHED;
            PG8_LDA(At, 0, 1); PG8_STAGE(PG8_SB(0, 0), b2, RB); PG8_STAGE(PG8_SB(0, 1), b2 + hB2, RB); PG8_STAGE(PG8_SA(0, 0), a2, RA);
            PG8_WAIT_V(8); PG8_WAIT_L(0); PG8_BAR; PG8_MMA(1, 0, At, B0); PG8_MMA(1, 1, At, B1); PG8_BAR; PG8_SCHED;
            PG8_LDB(B0, 1, 0); PG8_LDB(B1, 1, 1); PG8_SCHED; PG8_LDA(At, 1, 0); PG8_STAGE(PG8_SA(0, 1), a2 + hA2, RA);
            PG8_WAIT_V(8); PG8_WAIT_L(0); PG8_BAR; PG8_MMA(0, 0, At, B0); PG8_MMA(0, 1, At, B1); PG8_BAR; PG8_SCHED;
            PG8_LDA(At, 1, 1); PG8_STAGE(PG8_SB(1, 0), b3, RB); PG8_STAGE(PG8_SB(1, 1), b3 + hB2, RB); PG8_STAGE(PG8_SA(1, 0), a3, RA);
            PG8_WAIT_V(8); PG8_WAIT_L(0); PG8_BAR; PG8_MMA(1, 0, At, B0); PG8_MMA(1, 1, At, B1); PG8_BAR; PG8_SCHED;
        }
        if (wr == 0) PG8_BAR;
        E(acc, cur, wr, wc, fr, fq);
        if (!has_next) break;
        cur = nxt; cA = nA; cB = nB; ++ui;
        if (wr == 1) PG8_BAR;
    }
    PG8_WAIT_V(0);
    PG8_BAR;
#undef PG8_SA
#undef PG8_SB
#undef PG8_STAGE
#undef PG8_LDA
#undef PG8_LDB
#undef PG8_MMA
#undef PG8_WAIT_V
#undef PG8_WAIT_L
#undef PG8_BAR
#undef PG8_SCHED
}
__device__ __forceinline__ void tile_order(int L, int nM, int nN, int& pm, int& pn) {
    constexpr int NXCD = 8, WGM = 8;
    const int nwg = nM * nN; int wgid = L; { const int q = nwg / NXCD, r = nwg % NXCD, xcd = wgid % NXCD, off = wgid / NXCD; wgid = (xcd < r ? xcd * (q + 1) : r * (q + 1) + (xcd - r) * q) + off; }
    const int nig = WGM * nN, gid = wgid / nig, fm = gid * WGM, gsz = (nM - fm) < WGM ? (nM - fm) : WGM;
    pm = fm + ((wgid % nig) % gsz); pn = (wgid % nig) / gsz;
}
}
typedef GAS unsigned gu32;
#define RLX_AGENT __ATOMIC_RELAXED, __HIP_MEMORY_SCOPE_AGENT
#define XB_TMO      128
#define XB_XCNT(j)  (256  + 64 * (j))
#define XB_XSUB(j)  (1280 + 64 * (j))
#define XB_XGEN(j)  (2304 + 64 * (j))
#define XB_TOP      3328
#define XB_TOPGEN   3392
#define XCD_BAR_WORDS 3456
#define XB_SPIN_CAP (1u << 18)

__device__ __forceinline__ unsigned xb_ld(unsigned* p)              { return __hip_atomic_load(p, __ATOMIC_RELAXED, __HIP_MEMORY_SCOPE_AGENT); }
__device__ __forceinline__ unsigned xb_add(unsigned* p, unsigned v) { return __hip_atomic_fetch_add(p, v, __ATOMIC_RELAXED, __HIP_MEMORY_SCOPE_AGENT); }
__device__ __forceinline__ unsigned xb_xcc_id() { return (unsigned)__builtin_amdgcn_s_getreg((3 << 11) | 20) & 0xFu; }
#define XB_SPIN(cond, bar) do { unsigned _sp = 0; while (cond) { __builtin_amdgcn_s_sleep(1); \
    if ((++_sp & 255u) == 0u) { if (xb_ld(&(bar)[XB_TMO])) break; if (_sp > XB_SPIN_CAP) { atomicAdd(&(bar)[XB_TMO], 1u); break; } } } } while (0)

struct XcdBarrier {
    unsigned* bar; unsigned x;
    volatile LAS unsigned* st;
};

__device__ __forceinline__ XcdBarrier xcd_barrier_post(unsigned* bar, volatile LAS unsigned* st) {
    XcdBarrier b; b.bar = bar; b.x = xb_xcc_id(); b.st = st;
    if (threadIdx.x == 0) (void)xb_add(&bar[XB_XCNT(b.x)], 1u);
    return b;
}
__device__ __forceinline__ void xcd_barrier_complete(unsigned* bar, unsigned x, unsigned& nloc, unsigned& nx) {
    const unsigned G = gridDim.x * gridDim.y * gridDim.z;
    unsigned sum, cnt, mine, sp = 0u;
    for (;;) {
        sum = 0u; cnt = 0u; mine = 0u;
#pragma unroll
        for (unsigned j = 0; j < 16; ++j) { const unsigned c = xb_ld(&bar[XB_XCNT(j)]); sum += c; cnt += (c > 0u) ? 1u : 0u; mine = (j == x) ? c : mine; }
        if (sum == G) break;
        __builtin_amdgcn_s_sleep(1);
        if ((++sp & 255u) == 0u) { if (xb_ld(&bar[XB_TMO])) break; if (sp > XB_SPIN_CAP) { atomicAdd(&bar[XB_TMO], 1u); break; } }
    }
    nloc = mine > 0u ? mine : 1u; nx = cnt > 0u ? cnt : 1u;
}

__device__ __forceinline__ void xcd_barrier(const XcdBarrier& b) {
    asm volatile("s_waitcnt vmcnt(0)" ::: "memory");
    __syncthreads();
    if (threadIdx.x == 0) {
        unsigned* bar = b.bar;
        __builtin_amdgcn_s_waitcnt(0);
        unsigned nloc = b.st[0], nx = b.st[1];
        if (nloc == 0u) { xcd_barrier_complete(bar, b.x, nloc, nx); b.st[0] = nloc; b.st[1] = nx; }
        const unsigned old = xb_add(&bar[XB_XSUB(b.x)], 1u);
        const unsigned gen = old / nloc;
        if (old + 1u == (gen + 1u) * nloc) {
            __builtin_amdgcn_fence(__ATOMIC_RELEASE, "agent");
            asm volatile("s_waitcnt vmcnt(0)" ::: "memory");
            const unsigned og = xb_add(&bar[XB_TOP], 1u);
            const unsigned tg = og / nx;
            if (og + 1u == (tg + 1u) * nx) xb_add(&bar[XB_TOPGEN], 1u);
            else XB_SPIN(xb_ld(&bar[XB_TOPGEN]) == tg, bar);
            __builtin_amdgcn_fence(__ATOMIC_ACQUIRE, "agent");
            xb_add(&bar[XB_XGEN(b.x)], 1u);
            asm volatile("s_waitcnt vmcnt(0)" ::: "memory");
        } else {
            XB_SPIN(xb_ld(&bar[XB_XGEN(b.x)]) == gen, bar);
            __builtin_amdgcn_fence(__ATOMIC_ACQUIRE, "agent");
            asm volatile("s_waitcnt vmcnt(0)" ::: "memory");
        }
    }
    __syncthreads();
}
namespace epi {
constexpr int L_EPI = 131072, PITCH = 144, WAVE_BYTES = 16 * PITCH;
__device__ __forceinline__ LAS unsigned char* wave_stage(LAS unsigned char* lds, int wid) { return lds + L_EPI + wid * WAVE_BYTES; }
__device__ __forceinline__ void put_bf16(LAS unsigned char* st, int fr, int fq, int bj, u32x4 w) { *(LAS u32x4*)(st + fr * PITCH + bj * 64 + fq * 16) = w; }
__device__ __forceinline__ u32x4 get16(LAS unsigned char* st, int lane, int half) { return *(const LAS u32x4*)(st + ((lane >> 3) + 8 * half) * PITCH + (lane & 7) * 16); }
__device__ __forceinline__ void put_f32(LAS unsigned char* st, int fr, int fq, f32x4 v0, f32x4 v1) { *(LAS f32x4*)(st + fr * PITCH + fq * 32) = v0; *(LAS f32x4*)(st + fr * PITCH + fq * 32 + 16) = v1; }
__device__ __forceinline__ f32x4 get_f32(LAS unsigned char* st, int lane, int half) { return *(const LAS f32x4*)(st + ((lane >> 3) + 8 * half) * PITCH + (lane & 7) * 16); }
__device__ __forceinline__ void putrow_f32(LAS unsigned char* st, int lane, int half, f32x4 v) { *(LAS f32x4*)(st + ((lane >> 3) + 8 * half) * PITCH + (lane & 7) * 16) = v; }
__device__ __forceinline__ void getfrag_f32(LAS unsigned char* st, int fr, int fq, f32x4& v0, f32x4& v1) { v0 = *(const LAS f32x4*)(st + fr * PITCH + fq * 32); v1 = *(const LAS f32x4*)(st + fr * PITCH + fq * 32 + 16); }
}
struct Args {
    const float* in[24];
    float* out; unsigned char* ws;
    int ph_lo, ph_hi;
};
struct Frame {
    LAS unsigned char* lds;
    int tid, lane, wave, G, bid;
    const float* const* in;
    float* out; unsigned char* ws;
};
enum In { I_XP = 0, I_XS, I_CAK, I_CAV, I_CBK, I_CBV, I_CMK, I_CMV, I_MEM, I_NORM_IN, I_W_IN, I_RELB, I_LQ1, I_LK1, I_LQ2, I_LK2, I_SUBLN, I_NORM_MEM, I_W_MEMKV, I_WBA, I_WBB, I_WBM, I_WOUT, I_NORM_F };

__device__ __forceinline__ bf16_t* slot_ptr(unsigned char* ws, int s) { return (bf16_t*)(ws + WS_SLOT0 + (size_t)(s >> 1) * PAIR_BYTES) + (s & 1) * BW; }

__device__ __forceinline__ void p0_transpose_item(const float* W, int N, bf16_t* WT, int k0, int n0, int dn0, LAS float* scr, int lane) {
#pragma unroll 8
    for (int i = 0; i < 32; ++i) { const int kk = 2 * i + (lane >> 5); scr[kk * 33 + (lane & 31)] = W[(size_t)(k0 + kk) * N + n0 + (lane & 31)]; }
    LDS_WAIT(); asm volatile("" ::: "memory");
    const int c = lane & 7;
#pragma unroll
    for (int j = 0; j < 4; ++j) { const int n = (lane >> 3) + 8 * j; const LAS float* s = scr + (8 * c) * 33 + n;
        u32x4 o; o.x = cvtpk(s[0 * 33], s[1 * 33]); o.y = cvtpk(s[2 * 33], s[3 * 33]); o.z = cvtpk(s[4 * 33], s[5 * 33]); o.w = cvtpk(s[6 * 33], s[7 * 33]);
        *(u32x4*)(WT + (size_t)(dn0 + n) * SLD + k0 + 8 * c) = o; }
    LDS_WAIT(); asm volatile("" ::: "memory");
}
__device__ __forceinline__ int win_dest(int n0) {
    const int tb = (n0 & 255) >> 5;
    return (n0 & ~255) + 32 * (4 * (tb & 1) + (tb >> 1));
}
__device__ __forceinline__ void rms_row_to_bf16(const float* xrow, const float* g, bf16_t* orow, int lane) {
    const f32x4* xr = (const f32x4*)xrow + lane; const f32x4* gr = (const f32x4*)g + lane;
    f32x4 v[4]; float s = 0.f;
#pragma unroll
    for (int j = 0; j < 4; ++j) { v[j] = xr[64 * j]; s += (v[j].x * v[j].x + v[j].y * v[j].y) + (v[j].z * v[j].z + v[j].w * v[j].w); }
    const float r = 1.0f / sqrtf(wave_sum(s) * (1.f / DM) + RMS_EPS);
    u32x2* o8 = (u32x2*)orow + lane;
#pragma unroll
    for (int j = 0; j < 4; ++j) { const f32x4 gg = gr[64 * j]; u32x2 w; w.x = cvtpk(v[j].x * r * gg.x, v[j].y * r * gg.y); w.y = cvtpk(v[j].z * r * gg.z, v[j].w * r * gg.w); o8[64 * j] = w; }
}
__device__ __forceinline__ void cvt_cache(const float* src, bf16_t* dst, int nb, int rows, int drows, int gtid, int gthreads) {
    const int per_b = rows * 64, total = nb * per_b;
    for (int it = gtid; it < total; it += gthreads) {
        const int b = it / per_b, r = it - b * per_b;
        const f32x4* s = (const f32x4*)(src + (size_t)it * 8); const f32x4 a = s[0], c = s[1];
        u32x4 o; o.x = cvtpk(a.x, a.y); o.y = cvtpk(a.z, a.w); o.z = cvtpk(c.x, c.y); o.w = cvtpk(c.z, c.w);
        *(u32x4*)(dst + ((size_t)b * drows + (r >> 6)) * SLD + (r & 63) * 8) = o;
    }
}
__device__ __forceinline__ void zero_rows(bf16_t* dst, int nb, int r0, int r1, int drows, int gtid, int gthreads) {
    const int per_b = (r1 - r0) * 64, total = nb * per_b;
    for (int it = gtid; it < total; it += gthreads) { const int b = it / per_b, r = it - b * per_b; *(u32x4*)(dst + ((size_t)b * drows + r0 + (r >> 6)) * SLD + (r & 63) * 8) = (u32x4){0u, 0u, 0u, 0u}; }
}
__device__ __forceinline__ void p0_prologue(Frame& F) {
    LAS float* scr = (LAS float*)(F.lds + F.wave * 16384);
    const int gw = F.bid * NWAVES + F.wave, NGW = F.G * NWAVES, lane = F.lane;
    const int gtid = F.bid * NTHREADS + F.tid, NGT = F.G * NTHREADS;
    unsigned char* ws = F.ws;
    bf16_t* WTIN = (bf16_t*)(ws + WS_WTIN); bf16_t* WTBR = (bf16_t*)(ws + WS_WTBR); bf16_t* WTOUT = (bf16_t*)(ws + WS_WTOUT);
    constexpr int I_IN = (DM / 64) * (8192 / 32), I_MEMKV = (DM / 64) * (1024 / 32), I_BR = (BW / 64) * (DM / 32), I_OUT = (DM / 64) * (DM / 32);
    constexpr int NITEMS = I_IN + I_MEMKV + 3 * I_BR + I_OUT;
    for (int it = gw; it < NITEMS; it += NGW) {
        int r = it;
        if (r < I_IN) { const int nb = r % 256, kb = r / 256; p0_transpose_item(F.in[I_W_IN], 8192, WTIN, 64 * kb, 32 * nb, win_dest(32 * nb), scr, lane); continue; } r -= I_IN;
        if (r < I_MEMKV) { const int nb = r % 32, kb = r / 32; p0_transpose_item(F.in[I_W_MEMKV], 1024, WTIN + (size_t)8192 * DM, 64 * kb, 32 * nb, win_dest(32 * nb), scr, lane); continue; } r -= I_MEMKV;
        if (r < 3 * I_BR) { const int br = r / I_BR, q = r % I_BR, nb = q % 32, kb = q / 32; p0_transpose_item(F.in[I_WBA + br], DM, WTBR + (size_t)br * DM * SLD, 64 * kb, 32 * nb, win_dest(32 * nb), scr, lane); continue; } r -= 3 * I_BR;
        { const int nb = r % 32, kb = r / 32; p0_transpose_item(F.in[I_WOUT], DM, WTOUT, 64 * kb, 32 * nb, win_dest(32 * nb), scr, lane); }
    }
    bf16_t* H = (bf16_t*)F.out;
    for (int m = gw; m < ROWS + MEMROWS; m += NGW) {
        bf16_t* orow = H + (size_t)m * DM;
        if (m < TOK) rms_row_to_bf16(F.in[I_XP] + (size_t)m * DM, F.in[I_NORM_IN], orow, lane);
        else if (m < TOK + STOK) rms_row_to_bf16(F.in[I_XS] + (size_t)(m - TOK) * DM, F.in[I_NORM_IN], orow, lane);
        else if (m < ROWS) { u32x2* o8 = (u32x2*)orow + lane; for (int j = 0; j < 4; ++j) o8[64 * j] = (u32x2){0u, 0u}; }
        else rms_row_to_bf16(F.in[I_MEM] + (size_t)(m - ROWS) * DM, F.in[I_NORM_MEM], orow, lane);
    }
    cvt_cache(F.in[I_CAK], (bf16_t*)(ws + WS_SKVA), SBATCH, APAST, SKA_ROWS, gtid, NGT);
    cvt_cache(F.in[I_CAV], (bf16_t*)(ws + WS_SKVA) + BW, SBATCH, APAST, SKA_ROWS, gtid, NGT);
    cvt_cache(F.in[I_CBK], (bf16_t*)(ws + WS_SKVB), SBATCH, PAST, SKB_ROWS, gtid, NGT);
    cvt_cache(F.in[I_CBV], (bf16_t*)(ws + WS_SKVB) + BW, SBATCH, PAST, SKB_ROWS, gtid, NGT);
    cvt_cache(F.in[I_CMK], (bf16_t*)(ws + WS_SMKV), SBATCH, NMEM, NMEM, gtid, NGT);
    cvt_cache(F.in[I_CMV], (bf16_t*)(ws + WS_SMKV) + BW, SBATCH, NMEM, NMEM, gtid, NGT);
    zero_rows((bf16_t*)(ws + WS_SKVA), SBATCH, APAST + STEP, SKA_ROWS, SKA_ROWS, gtid, NGT);
    zero_rows((bf16_t*)(ws + WS_SKVA) + BW, SBATCH, APAST + STEP, SKA_ROWS, SKA_ROWS, gtid, NGT);
    zero_rows((bf16_t*)(ws + WS_SKVB), SBATCH, PAST + STEP, SKB_ROWS, SKB_ROWS, gtid, NGT);
    zero_rows((bf16_t*)(ws + WS_SKVB) + BW, SBATCH, PAST + STEP, SKB_ROWS, SKB_ROWS, gtid, NGT);
    float* rope = (float*)(ws + WS_ROPE);
    for (int it = gtid; it < (PAST + STEP) * 32; it += NGT) {
        const int pos = it >> 5, i = it & 31;
        const float inv = 1.0f / powf(10000.0f, (float)(2 * i) / 64.0f);
        const float ang = (float)pos * inv;
        rope[pos * 64 + i] = cosf(ang); rope[pos * 64 + 32 + i] = sinf(ang);
    }
    if (F.bid == 0) {
        unsigned* ctl = (unsigned*)(ws + WS_CTL);
        if (F.wave == 0) {
            const float a = F.in[I_LQ1][lane] * F.in[I_LK1][lane], b = F.in[I_LQ2][lane] * F.in[I_LK2][lane];
            const float sa = wave_sum(a), sb = wave_sum(b);
            if (lane == 0) ((float*)ctl)[CW_LAM] = expf(sa) - expf(sb) + LAM_INIT;
        }
        if (F.wave == 1 && lane < 16) { ctl[CW_QUEUE + 64 * lane] = 0u; ctl[CW_QUEUE + 1024 + 64 * lane] = 0u; }
    }
}

constexpr int P1_NM = TOK / 256, P1_NN = NPROJ / 256;
constexpr int P1_MAIN = P1_NM * P1_NN, P1_SAMPLE = P1_NN, P1_MEMKV = (MEMROWS / 256) * 4, P1_UNITS = P1_MAIN + P1_SAMPLE + P1_MEMKV;
struct P1Sched {
    const char* H; const char* WT; int G, c;
    __device__ __forceinline__ bool next(int i, pg8::GUnit& u) const {
        const int L = i * G + c; if (L >= P1_UNITS) return false;
        int pm, pn, kind = 0; int brow;
        if (L < P1_MAIN) { pg8::tile_order(L, P1_NM, P1_NN, pm, pn); brow = 256 * pn; }
        else if (L < P1_MAIN + P1_SAMPLE) { pm = P1_NM; pn = L - P1_MAIN; brow = 256 * pn; }
        else { const int e = L - P1_MAIN - P1_SAMPLE; pm = (ROWS / 256) + (e >> 2); pn = e & 3; brow = 8192 + 256 * pn; kind = 1; }
        u.a = H + (size_t)pm * 256 * (DM * 2); u.b = WT + (size_t)brow * (DM * 2); u.nt = DM / 64; u.kind = kind; u.pm = pm; u.pn = pn;
        return true;
    }
};
struct P1Epi {
    unsigned char* ws; float* out; const float* rope; int dry;
    __device__ __forceinline__ void operator()(f32x4 (&acc)[2][2][4][2], const pg8::GUnit& u, int wr, int wc, int fr, int fq) const {
        const int pn = u.pn;
        if (dry) {
#pragma unroll
            for (int ai = 0; ai < 2; ++ai)
#pragma unroll
                for (int m = 0; m < 4; ++m)
#pragma unroll
                    for (int bj = 0; bj < 2; ++bj) { asm volatile("" :: "v"(acc[ai][bj][m][0]), "v"(acc[ai][bj][m][1])); acc[ai][bj][m][0] = (f32x4){0.f, 0.f, 0.f, 0.f}; acc[ai][bj][m][1] = (f32x4){0.f, 0.f, 0.f, 0.f}; }
            return;
        }
        if (u.kind == 1) {
            const int half = pn >> 1; bf16_t* dstb = (bf16_t*)(ws + WS_MKV) + half * BW; float* dstf = out + (half ? O_MV : O_MK);
#pragma unroll
            for (int ai = 0; ai < 2; ++ai)
#pragma unroll
                for (int m = 0; m < 4; ++m) {
                    const int mrow = (u.pm - ROWS / 256) * 256 + ai * 128 + wr * 64 + m * 16 + fr;
#pragma unroll
                    for (int bj = 0; bj < 2; ++bj) {
                        const int col = (pn & 1) * 256 + wc * 64 + bj * 32 + 8 * fq; const f32x4 v0 = acc[ai][bj][m][0], v1 = acc[ai][bj][m][1];
                        u32x4 w; w.x = cvtpk(v0[0], v0[1]); w.y = cvtpk(v0[2], v0[3]); w.z = cvtpk(v1[0], v1[1]); w.w = cvtpk(v1[2], v1[3]);
                        *(u32x4*)(dstb + (size_t)mrow * SLD + col) = w;
                        float* fo = dstf + (size_t)mrow * BW + col; *(f32x4*)fo = v0; *(f32x4*)(fo + 4) = v1;
                        acc[ai][bj][m][0] = (f32x4){0.f, 0.f, 0.f, 0.f}; acc[ai][bj][m][1] = (f32x4){0.f, 0.f, 0.f, 0.f};
                    }
                }
            return;
        }
        const int creg = pn >> 1;
        const int region = creg == 0 ? S_AQ : creg == 1 ? S_AK : creg == 2 ? S_AV : creg == 3 ? S_AZ : creg == 4 ? S_BQ : creg == 5 ? S_BK : creg == 6 ? S_BV : creg == 7 ? S_BZ : creg == 8 ? S_MQ : S_MZ;
        const bool is_rope = (region == S_BQ || region == S_BK);
        const bool is_silu = (region == S_AZ || region == S_BZ || region == S_MZ);
        const float scale = (region == S_AQ || region == S_BQ) ? 0.125f * LOG2E : (region == S_MQ ? 0.08838834764831845f * LOG2E : 1.0f);
        const int fmode = (region == S_AK || region == S_AV) ? 1 : ((region == S_BK || region == S_BV) ? 2 : 0);
        const bool sample = (u.pm == P1_NM);
        bf16_t* slot = slot_ptr(ws, region);
        float* fprompt = out + (region == S_AK ? O_AK : region == S_AV ? O_AV : region == S_BK ? O_BK : O_BV);
        float* fsample = out + (region == S_AK ? O_SAK : region == S_AV ? O_SAV : region == S_BK ? O_SBK : O_SBV);
        bf16_t* scache = (bf16_t*)(ws + ((region == S_AK || region == S_AV) ? WS_SKVA : WS_SKVB)) + ((region == S_AV || region == S_BV) ? BW : 0);
        const int crows = (fmode == 1) ? SKA_ROWS : SKB_ROWS, cpast = (fmode == 1) ? APAST : PAST;
#pragma unroll
        for (int ai = 0; ai < 2; ++ai)
#pragma unroll
            for (int m = 0; m < 4; ++m) {
                const int row = u.pm * 256 + ai * 128 + wr * 64 + m * 16 + fr;
                f32x4 v[2][2];
#pragma unroll
                for (int bj = 0; bj < 2; ++bj) { v[bj][0] = acc[ai][bj][m][0]; v[bj][1] = acc[ai][bj][m][1];
                    acc[ai][bj][m][0] = (f32x4){0.f, 0.f, 0.f, 0.f}; acc[ai][bj][m][1] = (f32x4){0.f, 0.f, 0.f, 0.f}; }
                if (is_rope) {
                    const int pos = sample ? (PAST + ((row - TOK) & 15)) : (row & (SEQ - 1));
                    const float* rp = rope + (size_t)pos * 64 + 8 * fq;
                    const f32x4 c0 = *(const f32x4*)rp, c1 = *(const f32x4*)(rp + 4), s0 = *(const f32x4*)(rp + 32), s1 = *(const f32x4*)(rp + 36);
                    const f32x4 x10 = v[0][0], x11 = v[0][1], x20 = v[1][0], x21 = v[1][1];
                    v[0][0] = x10 * c0 - x20 * s0; v[0][1] = x11 * c1 - x21 * s1;
                    v[1][0] = x10 * s0 + x20 * c0; v[1][1] = x11 * s1 + x21 * c1;
                }
#pragma unroll
                for (int bj = 0; bj < 2; ++bj) {
                    const int col = (pn & 1) * 256 + wc * 64 + bj * 32 + 8 * fq;
                    f32x4 v0 = v[bj][0], v1 = v[bj][1];
                    if (fmode) {
                        if (!sample) {
                            if (fmode == 2) { float* fo = fprompt + (size_t)row * BW + col; *(f32x4*)fo = v0; *(f32x4*)(fo + 4) = v1; }
                            else { const int s = row & (SEQ - 1); if (s >= SEQ - APAST) { float* fo = fprompt + ((size_t)(row >> 12) * APAST + (s - (SEQ - APAST))) * BW + col; *(f32x4*)fo = v0; *(f32x4*)(fo + 4) = v1; } }
                        } else if (row < TOK + STOK) {
                            const int sr = row - TOK; float* fo = fsample + (size_t)sr * BW + col; *(f32x4*)fo = v0; *(f32x4*)(fo + 4) = v1;
                        }
                    }
                    if (is_silu) {
#pragma unroll
                        for (int e = 0; e < 4; ++e) { v0[e] = v0[e] * fast_sigmoid(v0[e]); v1[e] = v1[e] * fast_sigmoid(v1[e]); }
                    }
                    v0 = v0 * scale; v1 = v1 * scale;
                    u32x4 w; w.x = cvtpk(v0[0], v0[1]); w.y = cvtpk(v0[2], v0[3]); w.z = cvtpk(v1[0], v1[1]); w.w = cvtpk(v1[2], v1[3]);
                    *(u32x4*)(slot + (size_t)row * SLD + col) = w;
                    if (fmode && sample && row < TOK + STOK) {
                        const int sr = row - TOK, sb = sr >> 4, t = sr & 15;
                        *(u32x4*)(scache + ((size_t)sb * crows + cpast + t) * SLD + col) = w;
                    }
                }
            }
    }
};
#ifndef P1_STAGGER_TICKS
#define P1_STAGGER_TICKS 0
#endif
__device__ __forceinline__ void stagger_start(int bid, unsigned ticks) {
    if (ticks && ((bid >> 3) & 1)) { const unsigned long long t0 = __builtin_amdgcn_s_memrealtime(); while (__builtin_amdgcn_s_memrealtime() - t0 < ticks) __builtin_amdgcn_s_sleep(32); }
    __syncthreads();
}
__device__ __forceinline__ void p1_phase(Frame& F, int dry = 0) {
    stagger_start(F.bid, P1_STAGGER_TICKS);
    P1Sched S{(const char*)F.out, (const char*)(F.ws + WS_WTIN), F.G, F.bid};
    P1Epi E{F.ws, F.out, (const float*)(F.ws + WS_ROPE), dry};
    pg8::gemm_phase<P1Epi, P1Sched>(F.lds, S, E);
}
#ifndef ATT_PROBE
#define ATT_PROBE 0
#endif
#ifndef ATT_EN_MASK
#define ATT_EN_MASK 7
#endif
namespace att {
constexpr int TILE_B = 16384;
constexpr int L_K0 = 0, L_K1 = TILE_B, L_V0 = 2 * TILE_B;
constexpr int STG_LD = 132;
constexpr int L_STAGE = 0, STG_WAVE = 32 * STG_LD * 4;
constexpr int L_WSF = 8 * STG_WAVE;
constexpr int L_BIAS = L_WSF + 8 * 256;
constexpr int L_MISC = L_BIAS + 2 * 272 * 4;
static_assert(L_MISC + 64 <= LDS_BYTES, "attention LDS map");
constexpr float NEG_BIG = -1e30f;

#define SBAR() __builtin_amdgcn_sched_barrier(0)
__device__ __forceinline__ float max3f(float a, float b, float c) { float r; asm("v_max3_f32 %0, %1, %2, %3" : "=v"(r) : "v"(a), "v"(b), "v"(c)); return r; }
__device__ __forceinline__ int crow(int r, int hi) { return (r & 3) + 8 * (r >> 2) + 4 * hi; }
__device__ __forceinline__ unsigned tile_off(unsigned row, unsigned ch) { return 256u * row + 16u * (ch ^ (((row & 3u) << 2) | ((row >> 2) & 3u))); }
typedef short v4i16_t __attribute__((ext_vector_type(4)));
__device__ __forceinline__ s16x4 vtr(LAS const unsigned char* p) { return __builtin_bit_cast(s16x4, __builtin_amdgcn_ds_read_tr16_b64_v4i16((LAS v4i16_t*)p)); }

struct Unit {
    const bf16_t* Q; const bf16_t* K; const bf16_t* V; bf16_t* Z;
    int t_begin, t_end;
    int nvalid;
    int kv_last;
    int qpos0;
    int head0;
};
struct Consts { const float* rel_bias; const float* subln; float lam; int dry; };

template <int MODE, bool SAMPLE, bool DEFER>
__device__ __forceinline__ void run_unit_w(LAS unsigned char* lds, const Unit& u, const Consts& cs) {
    constexpr int NKS = (MODE == 2) ? 8 : 4;
    constexpr int NDB = (MODE == 0) ? 2 : 4;
    constexpr float THR = 8.0f;
    int tid = threadIdx.x; asm volatile("" : "+v"(tid));
    const int lane = tid & 63, r32 = lane & 31, hi = lane >> 5;
    const int wid = __builtin_amdgcn_readfirstlane(tid >> 6);
    const int grp = (MODE == 2) ? 0 : (wid >> 2), sub = (MODE == 2) ? wid : (wid & 3);
    const int kc0 = (MODE == 2) ? 0 : 8 * grp;
    const int vc0 = (MODE == 0) ? 8 * grp : 0;
    const bool active = 32 * sub < u.nvalid;
    int wt0 = u.t_begin, wt1 = u.t_end;
    if (MODE != 2) { const int c = (u.qpos0 + 32 * sub) >> 6; wt1 = min(wt1, c + 1); if (MODE == 0) wt0 = max(wt0, c - 8); }
    if (!active) wt1 = wt0;
    LAS float* wsf = (LAS float*)(lds + L_WSF) + wid * 64;
    if (MODE == 0) { LAS float* bl = (LAS float*)(lds + L_BIAS);
        for (int i = tid; i < 2 * 257; i += NTHREADS) { const int h = i >= 257 ? 1 : 0, j = i - 257 * h; bl[h * 272 + j] = cs.rel_bias[(u.head0 + h) * 257 + j] * LOG2E; } }
    bf16x8 qr[NKS];
    { const bf16_t* qp = u.Q + (size_t)(32 * sub + r32) * SLD + ((MODE == 2) ? 0 : 64 * grp) + 8 * hi;
#pragma unroll
      for (int s = 0; s < NKS; ++s) qr[s] = *(const bf16x8*)(qp + 16 * s);
#pragma unroll
      for (int s = 0; s < NKS; ++s) asm volatile("" : "+v"(qr[s])); }
    const int srow0 = tid >> 4, sch = tid & 15;
    const unsigned so0 = tile_off(srow0, sch), so1 = tile_off(srow0 + 32, sch);
    const bf16_t* kg = u.K + (size_t)srow0 * SLD + 8 * sch; const bf16_t* vg = u.V + (size_t)srow0 * SLD + 8 * sch;
    u32x4 kreg0, kreg1, vreg0, vreg1;
#define LOAD_TILE(t) do { const size_t o_ = (size_t)(t) * 64 * SLD; kreg0 = *(const u32x4*)(kg + o_); kreg1 = *(const u32x4*)(kg + o_ + 32 * SLD); vreg0 = *(const u32x4*)(vg + o_); vreg1 = *(const u32x4*)(vg + o_ + 32 * SLD); } while (0)
#define WRITE_TILE(kb, vb) do { *(LAS u32x4*)(lds + (kb) + so0) = kreg0; *(LAS u32x4*)(lds + (kb) + so1) = kreg1; *(LAS u32x4*)(lds + (vb) + so0) = vreg0; *(LAS u32x4*)(lds + (vb) + so1) = vreg1; } while (0)
    const unsigned xk = ((r32 & 3u) << 2) | ((r32 >> 2) & 3u);
    const unsigned kbase = 256u * r32;
    const unsigned qv = (lane & 15) >> 2, pv = lane & 3, blk = (lane >> 4) & 1;
    const unsigned vrow = 4u * hi + qv;
    f32x16 o[NDB];
#pragma unroll
    for (int c = 0; c < NDB; ++c) o[c] = f32x16{};
    float m_run = NEG_BIG, l_run = 0.f;
    const int qpos_w = u.qpos0 + 32 * sub;

    constexpr bool defer = DEFER;
    bool pending = false;
    bf16x8 pa[4];
#define VREAD(dst, vbase, c) do { _Pragma("unroll") for (int ks = 0; ks < 4; ++ks) { \
        const unsigned ch_ = (unsigned)(vc0 + 4 * (c)) + 2u * blk + (pv >> 1); \
        dst[2 * ks] = vtr(lds + (vbase) + tile_off(16u * ks + vrow, ch_) + 8u * (pv & 1)); dst[2 * ks + 1] = vtr(lds + (vbase) + tile_off(16u * ks + 8u + vrow, ch_) + 8u * (pv & 1)); } } while (0)
#define VFRAG(src, ks) (bf16x8){src[2 * (ks)][0], src[2 * (ks)][1], src[2 * (ks)][2], src[2 * (ks)][3], src[2 * (ks) + 1][0], src[2 * (ks) + 1][1], src[2 * (ks) + 1][2], src[2 * (ks) + 1][3]}
#define PV_BLOCKS(vbase, PRE) do { s16x4 vb_[8]; if (!(PRE)) { VREAD(va, vbase, 0); } \
        _Pragma("unroll") for (int c = 0; c < NDB; c += 2) { \
            VREAD(vb_, vbase, c + 1); SBAR(); \
            _Pragma("unroll") for (int ks = 0; ks < 4; ++ks) o[c] = __builtin_amdgcn_mfma_f32_32x32x16_bf16(pa[ks], VFRAG(va, ks), o[c], 0, 0, 0); \
            SBAR(); if (c + 2 < NDB) { VREAD(va, vbase, c + 2); } SBAR(); \
            _Pragma("unroll") for (int ks = 0; ks < 4; ++ks) o[c + 1] = __builtin_amdgcn_mfma_f32_32x32x16_bf16(pa[ks], VFRAG(vb_, ks), o[c + 1], 0, 0, 0); \
            SBAR(); } } while (0)

    LOAD_TILE(u.t_begin);
    WRITE_TILE(L_K0, L_V0);
    __builtin_amdgcn_s_waitcnt(0x0F70);
    __syncthreads();
    const int ntile = u.t_end - u.t_begin;
    int vcur = 0;
    for (int i = 0; i < ntile; ++i) {
        const int t = u.t_begin + i; const int cur = i & 1;
        const int kb = cur ? L_K1 : L_K0, vb = L_V0 + vcur * TILE_B;
        const int vnext = (vcur == 2) ? 0 : vcur + 1, vprev = (vcur == 0) ? 2 : vcur - 1;
        const bool traffic = !((ATT_PROBE & 8) && cs.dry);
        if (i + 1 < ntile && traffic) LOAD_TILE(t + 1);
        s16x4 va[8];
        if (DEFER) { if (pending) { PV_BLOCKS(L_V0 + vprev * TILE_B, false); pending = false; } }
        if (t >= wt0 && t < wt1) {
            f32x16 p0, p1;
            if (MODE == 0) {
                const LAS float* bl = (const LAS float*)(lds + L_BIAS) + grp * 272;
                const int d0 = qpos_w - 64 * t;
                if (d0 - 63 >= 128) { const float bf = bl[256];
#pragma unroll
                    for (int r = 0; r < 16; ++r) { p0[r] = bf; p1[r] = bf; } }
                else {
#pragma unroll
                    for (int r = 0; r < 16; ++r) { const int dd = d0 + r32 - crow(r, hi);
                        p0[r] = bl[min(max(dd, -128), 128) + 128]; p1[r] = bl[min(max(dd - 32, -128), 128) + 128]; } }
            } else { p0 = f32x16{}; p1 = f32x16{}; }
            if (!((ATT_PROBE & 4) && cs.dry))
#pragma unroll
            for (int sb = 0; sb < NKS / 4; ++sb) {
                bf16x8 kf[8];
#pragma unroll
                for (int s4 = 0; s4 < 4; ++s4) { const unsigned co = 16u * ((unsigned)(kc0 + 2 * (4 * sb + s4) + hi) ^ xk);
                    kf[2 * s4] = *(const LAS bf16x8*)(lds + kb + kbase + co); kf[2 * s4 + 1] = *(const LAS bf16x8*)(lds + kb + 8192 + kbase + co); }
                SBAR();
#pragma unroll
                for (int s4 = 0; s4 < 4; ++s4) {
                    p0 = __builtin_amdgcn_mfma_f32_32x32x16_bf16(kf[2 * s4], qr[4 * sb + s4], p0, 0, 0, 0);
                    p1 = __builtin_amdgcn_mfma_f32_32x32x16_bf16(kf[2 * s4 + 1], qr[4 * sb + s4], p1, 0, 0, 0);
                }
                SBAR();
            }
            if (!defer && !((ATT_PROBE & 2) && cs.dry)) { VREAD(va, vb, 0); }
            if (SAMPLE) { if (t == u.t_end - 1 && u.kv_last < 64) {
#pragma unroll
                for (int r = 0; r < 16; ++r) { if (crow(r, hi) >= u.kv_last) p0[r] = NEG_BIG; if (32 + crow(r, hi) >= u.kv_last) p1[r] = NEG_BIG; } } }
            float mx;
            { float a = max3f(p0[0], p0[1], p1[0]), b = max3f(p0[2], p0[3], p1[1]); a = max3f(a, p1[2], p1[3]);
#pragma unroll
              for (int r = 4; r < 16; r += 4) { a = max3f(a, p0[r], p0[r + 1]); b = max3f(b, p0[r + 2], p0[r + 3]); a = max3f(a, p1[r], p1[r + 1]); b = max3f(b, p1[r + 2], p1[r + 3]); }
              mx = fmaxf(a, b); }
            { auto rr = __builtin_amdgcn_permlane32_swap(__float_as_uint(mx), __float_as_uint(mx), false, false); mx = fmaxf(__uint_as_float(rr[0]), __uint_as_float(rr[1])); }
            if (__any(mx > m_run + THR)) {
                const float mn = fmaxf(m_run, mx), f = __builtin_amdgcn_exp2f(m_run - mn);
                l_run *= f; m_run = mn;
                if (hi == 0) wsf[r32] = f;
                LDS_WAIT();
#pragma unroll
                for (int r = 0; r < 16; ++r) { const float fr_ = wsf[crow(r, hi)];
#pragma unroll
                    for (int c = 0; c < NDB; ++c) o[c][r] *= fr_; }
            }
            float ls = 0.f;
            if (!((ATT_PROBE & 1) && cs.dry)) {
#pragma unroll
            for (int r = 0; r < 16; ++r) { p0[r] = __builtin_amdgcn_exp2f(p0[r] - m_run); p1[r] = __builtin_amdgcn_exp2f(p1[r] - m_run); ls += p0[r] + p1[r]; }
            }
            l_run += ls;
#pragma unroll
            for (int ks = 0; ks < 4; ++ks) { const int b8 = 8 * (ks & 1); u32x4 w;
                if (ks < 2) { w.x = cvtpk(p0[b8], p0[b8 + 1]); w.y = cvtpk(p0[b8 + 2], p0[b8 + 3]); w.z = cvtpk(p0[b8 + 4], p0[b8 + 5]); w.w = cvtpk(p0[b8 + 6], p0[b8 + 7]); }
                else { w.x = cvtpk(p1[b8], p1[b8 + 1]); w.y = cvtpk(p1[b8 + 2], p1[b8 + 3]); w.z = cvtpk(p1[b8 + 4], p1[b8 + 5]); w.w = cvtpk(p1[b8 + 6], p1[b8 + 7]); }
                pa[ks] = __builtin_bit_cast(bf16x8, w); }
            if (!((ATT_PROBE & 2) && cs.dry)) { if (!DEFER) { PV_BLOCKS(vb, true); } else pending = true; }
        }
        if (i + 1 < ntile && traffic) { const int kn = cur ? L_K0 : L_K1, vn = L_V0 + vnext * TILE_B; WRITE_TILE(kn, vn); }
        if (traffic) __syncthreads();
        vcur = vnext;
    }
    if (DEFER) if (pending) { s16x4 va[8]; const int vlast = (vcur == 0) ? 2 : vcur - 1; PV_BLOCKS(L_V0 + vlast * TILE_B, false); }
    LDS_WAIT();
    __syncthreads();
#undef VREAD
#undef VFRAG
#undef PV_BLOCKS
#undef LOAD_TILE
#undef WRITE_TILE
    { float lt = l_run + __shfl_xor(l_run, 32); const float inv = active ? __builtin_amdgcn_rcpf(lt) : 0.f;
      if (hi == 0) wsf[32 + r32] = inv; LDS_WAIT(); }
    float rli[16];
#pragma unroll
    for (int r = 0; r < 16; ++r) rli[r] = wsf[32 + crow(r, hi)];
    if (MODE != 1) {
        LAS float* stg = (LAS float*)(lds + L_STAGE + wid * STG_WAVE);
#pragma unroll
        for (int c = 0; c < NDB; ++c)
#pragma unroll
            for (int r = 0; r < 16; ++r) stg[crow(r, hi) * STG_LD + 32 * c + r32] = o[c][r] * rli[r];
        LDS_WAIT(); asm volatile("" ::: "memory");
        constexpr int NC = 32 * NDB, HC = NC / 2;
        const int row = lane >> 1, half = lane & 1;
        if (32 * sub + row < u.nvalid) {
            bf16_t* zp = u.Z + (size_t)(32 * sub + row) * SLD + ((MODE == 0) ? 64 * grp : 0) + half * HC;
            const LAS float* sp = stg + row * STG_LD + half * HC;
#pragma unroll
            for (int j = 0; j < HC / 8; ++j) {
                const f32x4 a = *(const LAS f32x4*)(sp + 8 * j), b = *(const LAS f32x4*)(sp + 8 * j + 4);
                const u32x4 z = *(const u32x4*)(zp + 8 * j);
                u32x4 w; w.x = cvtpk(a[0] * bf_lo(z.x), a[1] * bf_hi(z.x)); w.y = cvtpk(a[2] * bf_lo(z.y), a[3] * bf_hi(z.y));
                w.z = cvtpk(b[0] * bf_lo(z.z), b[1] * bf_hi(z.z)); w.w = cvtpk(b[2] * bf_lo(z.w), b[3] * bf_hi(z.w));
                if (!((ATT_EN_MASK >> MODE) & 1)) w = (u32x4){0u, 0u, 0u, 0u};
                if (!cs.dry) *(u32x4*)(zp + 8 * j) = w;
            }
        }
        LDS_WAIT();
        __syncthreads();
    } else {
        LAS float* stg = (LAS float*)(lds + L_STAGE + sub * STG_WAVE);
        if (grp == 1) {
#pragma unroll
            for (int c = 0; c < NDB; ++c)
#pragma unroll
                for (int r = 0; r < 16; ++r) stg[crow(r, hi) * STG_LD + 32 * c + r32] = o[c][r] * rli[r];
        }
        LDS_WAIT(); __syncthreads();
        if (grp == 0) {
            const float lam = cs.lam;
#pragma unroll
            for (int c = 0; c < NDB; ++c)
#pragma unroll
                for (int r = 0; r < 16; ++r) { LAS float* p = stg + crow(r, hi) * STG_LD + 32 * c + r32; *p = o[c][r] * rli[r] - lam * (*p); }
        }
        LDS_WAIT(); __syncthreads();
        {
            const int urow = 16 * wid + (lane >> 2), quarter = lane & 3;
            const LAS float* sp = (const LAS float*)(lds + L_STAGE + (urow >> 5) * STG_WAVE) + (urow & 31) * STG_LD + 32 * quarter;
            f32x4 vv[8]; float ss = 0.f;
#pragma unroll
            for (int j = 0; j < 8; ++j) { vv[j] = *(const LAS f32x4*)(sp + 4 * j); ss += (vv[j][0] * vv[j][0] + vv[j][1] * vv[j][1]) + (vv[j][2] * vv[j][2] + vv[j][3] * vv[j][3]); }
            ss += __shfl_xor(ss, 1); ss += __shfl_xor(ss, 2);
            const float rn = (1.0f - LAM_INIT) / sqrtf(ss * (1.0f / 128.0f) + RMS_EPS);
            if (urow < u.nvalid) {
                bf16_t* zp = u.Z + (size_t)urow * SLD + 32 * quarter; const float* gp = cs.subln + 32 * quarter;
#pragma unroll
                for (int j = 0; j < 4; ++j) {
                    const f32x4 a = vv[2 * j], b = vv[2 * j + 1]; const f32x4 g0 = *(const f32x4*)(gp + 8 * j), g1 = *(const f32x4*)(gp + 8 * j + 4);
                    const u32x4 z = *(const u32x4*)(zp + 8 * j);
                    u32x4 w; w.x = cvtpk(a[0] * rn * g0[0] * bf_lo(z.x), a[1] * rn * g0[1] * bf_hi(z.x)); w.y = cvtpk(a[2] * rn * g0[2] * bf_lo(z.y), a[3] * rn * g0[3] * bf_hi(z.y));
                    w.z = cvtpk(b[0] * rn * g1[0] * bf_lo(z.z), b[1] * rn * g1[1] * bf_hi(z.z)); w.w = cvtpk(b[2] * rn * g1[2] * bf_lo(z.w), b[3] * rn * g1[3] * bf_hi(z.w));
                    if (!((ATT_EN_MASK >> 1) & 1)) w = (u32x4){0u, 0u, 0u, 0u};
                    if (!cs.dry) *(u32x4*)(zp + 8 * j) = w;
                }
            }
        }
        LDS_WAIT();
        __syncthreads();
    }
}

template <int MODE, bool SAMPLE>
__device__ __forceinline__ void run_unit(LAS unsigned char* lds, const Unit& u, const Consts& cs) {
    if (__builtin_amdgcn_readfirstlane(threadIdx.x >> 6) >= 4) run_unit_w<MODE, SAMPLE, true>(lds, u, cs); else run_unit_w<MODE, SAMPLE, false>(lds, u, cs);
}

constexpr int Q_SB = 4, Q_B = 256, Q_A = 256, Q_M = 128, Q_SA = 4, Q_SM = 4;
constexpr int Q_LEN = Q_SB + Q_B + Q_A + Q_M + Q_SA + Q_SM;
__device__ __forceinline__ int decode_unit(unsigned char* ws, int q, int idx, Unit& u) {
    auto S = [&](int s) { return slot_ptr(ws, s); };
    u.kv_last = 64; u.head0 = 0;
    if (idx < Q_SB) { const int sp = idx * 8 + q, b = sp >> 2, h = sp & 3; const size_t qo = (size_t)(TOK + STEP * b) * SLD + 128 * h, ko = (size_t)b * SKB_ROWS * SLD + 128 * h;
        u.Q = S(S_BQ) + qo; u.Z = S(S_BZ) + qo; u.K = (const bf16_t*)(ws + WS_SKVB) + ko; u.V = (const bf16_t*)(ws + WS_SKVB) + BW + ko;
        u.t_begin = 0; u.t_end = SKB_ROWS / 64; u.nvalid = STEP; u.kv_last = STEP; u.qpos0 = PAST; return 1; }
    idx -= Q_SB;
    if (idx < Q_B) { const int pair = (idx >> 5) * 8 + q, qt = 31 - (idx & 31), b = pair >> 2, h = pair & 3; const size_t ko = (size_t)b * SEQ * SLD + 128 * h, qo = ko + (size_t)(128 * qt) * SLD;
        u.Q = S(S_BQ) + qo; u.Z = S(S_BZ) + qo; u.K = S(S_BK) + ko; u.V = S(S_BV) + ko; u.t_begin = 0; u.t_end = 2 * qt + 2; u.nvalid = 128; u.qpos0 = 128 * qt; return 1; }
    idx -= Q_B;
    if (idx < Q_A) { const int pair = (idx >> 5) * 8 + q, cp = idx & 31, b = pair >> 2, hp = pair & 3; const size_t ko = (size_t)b * SEQ * SLD + 128 * hp, qo = ko + (size_t)(128 * cp) * SLD;
        u.Q = S(S_AQ) + qo; u.Z = S(S_AZ) + qo; u.K = S(S_AK) + ko; u.V = S(S_AV) + ko; u.t_begin = max(0, 2 * cp - 8); u.t_end = 2 * cp + 2; u.nvalid = 128; u.qpos0 = 128 * cp; u.head0 = 2 * hp; return 0; }
    idx -= Q_A;
    if (idx < Q_M) { const int pair = (idx >> 4) * 8 + q, qt = idx & 15, b = pair >> 2, h = pair & 3; const size_t qo = (size_t)(b * SEQ + 256 * qt) * SLD + 128 * h, ko = (size_t)b * NMEM * SLD + 128 * h;
        u.Q = S(S_MQ) + qo; u.Z = S(S_MZ) + qo; u.K = (const bf16_t*)(ws + WS_MKV) + ko; u.V = (const bf16_t*)(ws + WS_MKV) + BW + ko; u.t_begin = 0; u.t_end = 4; u.nvalid = 256; u.qpos0 = 0; return 2; }
    idx -= Q_M;
    if (idx < Q_SA) { const int sp = idx * 8 + q, b = sp >> 2, hp = sp & 3; const size_t qo = (size_t)(TOK + STEP * b) * SLD + 128 * hp, ko = (size_t)b * SKA_ROWS * SLD + 128 * hp;
        u.Q = S(S_AQ) + qo; u.Z = S(S_AZ) + qo; u.K = (const bf16_t*)(ws + WS_SKVA) + ko; u.V = (const bf16_t*)(ws + WS_SKVA) + BW + ko; u.t_begin = 0; u.t_end = SKA_ROWS / 64; u.nvalid = STEP; u.kv_last = STEP; u.qpos0 = APAST; u.head0 = 2 * hp; return 0; }
    idx -= Q_SA;
    { const int sp = idx * 8 + q, b = sp >> 2, h = sp & 3; const size_t qo = (size_t)(TOK + STEP * b) * SLD + 128 * h, ko = (size_t)b * NMEM * SLD + 128 * h;
        u.Q = S(S_MQ) + qo; u.Z = S(S_MZ) + qo; u.K = (const bf16_t*)(ws + WS_SMKV) + ko; u.V = (const bf16_t*)(ws + WS_SMKV) + BW + ko; u.t_begin = 0; u.t_end = 4; u.nvalid = STEP; u.qpos0 = 0; return 2; }
}
__device__ __forceinline__ unsigned xcc_id() { return (unsigned)__builtin_amdgcn_s_getreg((3 << 11) | 20) & 0x7u; }
}

__device__ __forceinline__ void p2_phase(Frame& F, int dry = 0) {
    using namespace att;
    unsigned* ctl = (unsigned*)(F.ws + WS_CTL);
    volatile LAS int* misc = (volatile LAS int*)(F.lds + L_MISC);
    Consts cs; cs.rel_bias = F.in[I_RELB]; cs.subln = F.in[I_SUBLN]; cs.lam = ((const float*)ctl)[CW_LAM]; cs.dry = dry;
    const int qbase = CW_QUEUE + (dry ? 1024 : 0);
    const int myq = (int)xcc_id();
    int qoff = 0;
#define P2_FETCH(dst) do { int r_ = -1; while (qoff < 8) { const int q_ = (myq + qoff) & 7; const unsigned idx_ = __hip_atomic_fetch_add(ctl + qbase + 64 * q_, 1u, __ATOMIC_RELAXED, __HIP_MEMORY_SCOPE_AGENT); \
        if (idx_ < (unsigned)Q_LEN) { r_ = (q_ << 16) | (int)idx_; break; } ++qoff; } (dst) = r_; } while (0)
    if (F.tid == 0) P2_FETCH(misc[0]);
    __syncthreads();
    for (;;) {
        const int code = misc[0];
        __syncthreads();
        if (code < 0) break;
        if (F.tid == 0) P2_FETCH(misc[0]);
        Unit u; const int mode = decode_unit(F.ws, code >> 16, code & 0xffff, u);
#ifdef P2_DRY_FILTER
        if (dry && !((P2_DRY_FILTER >> mode) & 1)) { __syncthreads(); continue; }
#endif
        if (u.nvalid == STEP) { if (mode == 0) run_unit<0, true>(F.lds, u, cs); else if (mode == 1) run_unit<1, true>(F.lds, u, cs); else run_unit<2, true>(F.lds, u, cs); }
        else { if (mode == 0) run_unit<0, false>(F.lds, u, cs); else if (mode == 1) run_unit<1, false>(F.lds, u, cs); else run_unit<2, false>(F.lds, u, cs); }
        __syncthreads();
    }
}
constexpr int P3_TILES = (TOK / 256) * 4 + 4;
struct P3Sched {
    const char* H; const char* WT; const char* WTBR; unsigned char* ws; int G, c;
    __device__ __forceinline__ bool next(int i, pg8::GUnit& u) const {
        const int tu = i / 6, j = i - 6 * tu; const int L = tu * G + c; if (L >= P3_TILES) return false;
        int pm, pn; if (L < 1024) pg8::tile_order(L, TOK / 256, 4, pm, pn); else { pm = TOK / 256; pn = L - 1024; }
        u.pm = pm; u.pn = pn; u.kind = j;
        if (j < 3) { u.a = H + (size_t)pm * 256 * (DM * 2); u.b = WT + (size_t)(NPROJ + 1024 * j + 256 * pn) * (DM * 2); u.nt = DM / 64; }
        else { const int b = j - 3; const int s = (b == 0) ? S_AZ : (b == 1 ? S_BZ : S_MZ);
            u.a = (const char*)(slot_ptr(ws, s) + (size_t)pm * 256 * SLD); u.b = WTBR + ((size_t)b * DM + 256 * pn) * (SLD * 2); u.nt = BW / 64; }
        return true;
    }
};
struct P3Epi {
    unsigned char* gst; bf16_t* mixed;
    __device__ __forceinline__ void operator()(f32x4 (&acc)[2][2][4][2], const pg8::GUnit& u, int wr, int wc, int fr, int fq) const {
        const int kind = u.kind; const unsigned toff = threadIdx.x * 16u;
        const unsigned char* pn_ = gst + (size_t)(kind >= 3 ? kind - 3 : 0) * 131072 + toff;
        const unsigned char* pd_ = gst + (size_t)(kind == 3 || kind == 4 ? kind - 2 : 0) * 131072 + toff;
        unsigned char* dst = gst + (size_t)(kind < 3 ? kind : 0) * 131072 + toff;
        bf16_t* mp = mixed + (size_t)(u.pm * 256 + wr * 64 + fr) * DM + u.pn * 256 + wc * 64 + 8 * fq;
#pragma unroll
        for (int ai = 0; ai < 2; ++ai) {
#pragma unroll
            for (int m = 0; m < 4; ++m) {
#pragma unroll
                for (int bj = 0; bj < 2; ++bj) {
                    const f32x4 v0 = acc[ai][bj][m][0], v1 = acc[ai][bj][m][1];
                    f32x4 m0 = (f32x4){0.f, 0.f, 0.f, 0.f}, m1 = (f32x4){0.f, 0.f, 0.f, 0.f};
                    if (kind < 3) {
                        f32x4 s0, s1;
#pragma unroll
                        for (int e = 0; e < 4; ++e) { s0[e] = fmaxf(fast_sigmoid(v0[e]), 1e-6f); s1[e] = fmaxf(fast_sigmoid(v1[e]), 1e-6f); }
                        u32x4 w; w.x = cvtpk(s0[0], s0[1]); w.y = cvtpk(s0[2], s0[3]); w.z = cvtpk(s1[0], s1[1]); w.w = cvtpk(s1[2], s1[3]);
                        *(u32x4*)dst = w;
                    } else if (kind < 5) {
                        const u32x4 gn = *(const u32x4*)pn_, gd = *(const u32x4*)pd_;
                        m0[0] = bf_lo(gn.x) * __builtin_amdgcn_rcpf(bf_lo(gd.x)); m0[1] = bf_hi(gn.x) * __builtin_amdgcn_rcpf(bf_hi(gd.x));
                        m0[2] = bf_lo(gn.y) * __builtin_amdgcn_rcpf(bf_lo(gd.y)); m0[3] = bf_hi(gn.y) * __builtin_amdgcn_rcpf(bf_hi(gd.y));
                        m1[0] = bf_lo(gn.z) * __builtin_amdgcn_rcpf(bf_lo(gd.z)); m1[1] = bf_hi(gn.z) * __builtin_amdgcn_rcpf(bf_hi(gd.z));
                        m1[2] = bf_lo(gn.w) * __builtin_amdgcn_rcpf(bf_lo(gd.w)); m1[3] = bf_hi(gn.w) * __builtin_amdgcn_rcpf(bf_hi(gd.w));
                    } else {
                        const u32x4 g = *(const u32x4*)pn_;
                        u32x4 w; w.x = cvtpk(v0[0] * bf_lo(g.x), v0[1] * bf_hi(g.x)); w.y = cvtpk(v0[2] * bf_lo(g.y), v0[3] * bf_hi(g.y));
                        w.z = cvtpk(v1[0] * bf_lo(g.z), v1[1] * bf_hi(g.z)); w.w = cvtpk(v1[2] * bf_lo(g.w), v1[3] * bf_hi(g.w));
                        *(u32x4*)(mp + bj * 32) = w;
                    }
                    acc[ai][bj][m][0] = v0 * m0; acc[ai][bj][m][1] = v1 * m1;
                    asm volatile("" : "+v"(acc[ai][bj][m][0]), "+v"(acc[ai][bj][m][1]));
                    pn_ += 8192; pd_ += 8192; dst += 8192;
                    asm volatile("" : "+v"(pn_), "+v"(pd_), "+v"(dst));
                }
                mp += 16 * DM;
                asm volatile("" : "+v"(mp) :: "memory");
            }
            mp += 64 * DM;
        }
    }
};
__device__ __forceinline__ void p3_phase(Frame& F) {
    P3Sched S{(const char*)F.out, (const char*)(F.ws + WS_WTIN), (const char*)(F.ws + WS_WTBR), F.ws, F.G, F.bid};
    P3Epi E{F.ws + WS_GSTASH + (size_t)F.bid * 393216, (bf16_t*)(F.ws + WS_MIXED)};
    pg8::gemm_phase<P3Epi, P3Sched>(F.lds, S, E);
}

constexpr int P4_TILES = (TOK / 256) * 4 + 4;
struct P4Sched {
    const char* A; const char* WT; int G, c;
    __device__ __forceinline__ bool next(int i, pg8::GUnit& u) const {
        const int L = i * G + c; if (L >= P4_TILES) return false;
        int pm, pn; if (L < 1024) pg8::tile_order(L, TOK / 256, 4, pm, pn); else { pm = TOK / 256; pn = L - 1024; }
        u.pm = pm; u.pn = pn; u.kind = 0; u.a = A + (size_t)pm * 256 * (DM * 2); u.b = WT + (size_t)(256 * pn) * (DM * 2); u.nt = DM / 64;
        return true;
    }
};
struct P4Epi {
    const float* xp; const float* xs; float* out; float* rowsq;
    __device__ __forceinline__ void operator()(f32x4 (&acc)[2][2][4][2], const pg8::GUnit& u, int wr, int wc, int fr, int fq) const {
        const bool sample = (u.pm == TOK / 256);
#pragma unroll
        for (int ai = 0; ai < 2; ++ai)
#pragma unroll
            for (int m = 0; m < 4; ++m) {
                const int row = u.pm * 256 + ai * 128 + wr * 64 + m * 16 + fr;
                const bool valid = !sample || row < TOK + STOK;
                const float* xr = sample ? xs + (size_t)(valid ? row - TOK : 0) * DM : xp + (size_t)row * DM;
                float* orow = sample ? out + O_YS + (size_t)(valid ? row - TOK : 0) * DM : out + O_Y + (size_t)row * DM;
                float ss = 0.f;
#pragma unroll
                for (int bj = 0; bj < 2; ++bj) {
                    const int col = u.pn * 256 + wc * 64 + bj * 32 + 8 * fq;
                    const f32x4 x0 = *(const f32x4*)(xr + col), x1 = *(const f32x4*)(xr + col + 4);
                    const f32x4 h0 = acc[ai][bj][m][0] + x0, h1 = acc[ai][bj][m][1] + x1;
                    ss += (h0[0] * h0[0] + h0[1] * h0[1]) + (h0[2] * h0[2] + h0[3] * h0[3]) + (h1[0] * h1[0] + h1[1] * h1[1]) + (h1[2] * h1[2] + h1[3] * h1[3]);
                    if (valid) { *(f32x4*)(orow + col) = h0; *(f32x4*)(orow + col + 4) = h1; }
                    acc[ai][bj][m][0] = (f32x4){0.f, 0.f, 0.f, 0.f}; acc[ai][bj][m][1] = (f32x4){0.f, 0.f, 0.f, 0.f};
                }
                ss += __shfl_xor(ss, 16); ss += __shfl_xor(ss, 32);
                if (fq == 0) rowsq[(size_t)row * 16 + u.pn * 4 + wc] = ss;
                asm volatile("" ::: "memory");
            }
    }
};
__device__ __forceinline__ void p4_phase(Frame& F) {
    P4Sched S{(const char*)(F.ws + WS_MIXED), (const char*)(F.ws + WS_WTOUT), F.G, F.bid};
    P4Epi E{F.in[I_XP], F.in[I_XS], F.out, (float*)(F.ws + WS_ROWSQ)};
    pg8::gemm_phase<P4Epi, P4Sched>(F.lds, S, E);
}

__device__ __forceinline__ void p5_phase(Frame& F, int dry = 0) {
    const int gw = F.bid * NWAVES + F.wave, NGW = F.G * NWAVES, lane = F.lane;
    const float* rowsq = (const float*)(F.ws + WS_ROWSQ);
    const f32x4* gr = (const f32x4*)F.in[I_NORM_F] + lane;
    f32x4 g[4];
#pragma unroll
    for (int j = 0; j < 4; ++j) g[j] = gr[64 * j];
    for (int m = gw; m < TOK + STOK; m += NGW) {
        float* orow = m < TOK ? F.out + O_Y + (size_t)m * DM : F.out + O_YS + (size_t)(m - TOK) * DM;
        const float part = (lane < 16) ? rowsq[(size_t)m * 16 + lane] : 0.f;
        const float r = 1.0f / sqrtf(wave_sum(part) * (1.f / DM) + RMS_EPS);
        f32x4* o = (f32x4*)orow + lane;
#pragma unroll
        for (int j = 0; j < 4; ++j) { const f32x4 v = o[64 * j] * r * g[j]; if (!dry) o[64 * j] = v; else asm volatile("" :: "v"(v)); }
    }
}
#ifndef MK_N_LAUNCHES
#define MK_N_LAUNCHES 1
#endif
constexpr int N_PHASES = 6;
__global__ void __launch_bounds__(NTHREADS, 2) mk_fwd(Args args) {
    extern __shared__ __attribute__((aligned(16))) unsigned char lds_raw[];
    Frame F;
    F.lds = (LAS unsigned char*)lds_raw;
    F.tid = threadIdx.x; F.lane = F.tid & 63; F.wave = __builtin_amdgcn_readfirstlane(F.tid >> 6);
    F.G = gridDim.x; F.bid = blockIdx.x;
    F.in = args.in; F.out = args.out; F.ws = args.ws;
    const int lo = args.ph_lo, hi = args.ph_hi;
#define IN(k) (lo <= (k) && (k) < hi)
#ifndef USE_CG_SYNC
#define USE_CG_SYNC 0
#endif
#if MK_N_LAUNCHES != 1
#define GRID_SYNC() do {} while (0)
#elif USE_CG_SYNC
#define GRID_SYNC() cg::this_grid().sync()
#else
    volatile LAS unsigned* barst = (volatile LAS unsigned*)(F.lds + L_BARST);
    if (F.tid < 2) barst[F.tid] = 0u;
    __syncthreads();
    const XcdBarrier bar = xcd_barrier_post((unsigned*)(args.ws + WS_CTL) + CW_BAR, barst);
#define GRID_SYNC() xcd_barrier(bar)
#endif
#ifndef REPEAT_PHASE
#define REPEAT_PHASE -1
#endif
    if (REPEAT_PHASE == 0) { p0_prologue(F); GRID_SYNC(); }
    if (IN(0)) { p0_prologue(F); if (IN(1)) GRID_SYNC(); }
    if (REPEAT_PHASE == 1) { p1_phase(F); GRID_SYNC(); }
    if (REPEAT_PHASE == 11) { p1_phase(F, 1); GRID_SYNC(); }
    if (IN(1)) { p1_phase(F); if (IN(2)) GRID_SYNC(); }
    if (REPEAT_PHASE == 2) { p2_phase(F, 1); GRID_SYNC(); }
    if (IN(2)) { p2_phase(F); if (IN(3)) GRID_SYNC(); }
    if (REPEAT_PHASE == 3) { p3_phase(F); GRID_SYNC(); }
    if (IN(3)) { p3_phase(F); if (IN(4)) GRID_SYNC(); }
    if (REPEAT_PHASE == 4) { p4_phase(F); GRID_SYNC(); }
    if (IN(4)) { p4_phase(F); if (IN(5)) GRID_SYNC(); }
    if (REPEAT_PHASE == 5) { p5_phase(F, 1); GRID_SYNC(); }
    if (IN(5)) { p5_phase(F); }
#undef IN
}

extern "C" void kernel_launch(void* const* d_in, const int* in_sizes, int n_in, void* d_out, int out_size, void* d_ws, size_t ws_size, hipStream_t stream) {
    static int grid = 0;
    if (grid == 0) {
        if (n_in != 24 || out_size != (int)O_TOTAL || ws_size < WS_END) { fprintf(stderr, "kernel_launch: unexpected problem (n_in %d, out %d, ws %zu)\n", n_in, out_size, ws_size); grid = -1; return; }
        int dev = 0, cus = 0, per_cu = 0;
        if (hipGetDevice(&dev) != hipSuccess || hipDeviceGetAttribute(&cus, hipDeviceAttributeMultiprocessorCount, dev) != hipSuccess) { grid = -1; return; }
        if (hipFuncSetAttribute((const void*)mk_fwd, hipFuncAttributeMaxDynamicSharedMemorySize, LDS_BYTES) != hipSuccess) { fprintf(stderr, "kernel_launch: hipFuncSetAttribute failed\n"); grid = -1; return; }
        if (hipOccupancyMaxActiveBlocksPerMultiprocessor(&per_cu, (const void*)mk_fwd, NTHREADS, LDS_BYTES) != hipSuccess || per_cu < 1) { fprintf(stderr, "kernel_launch: occupancy query says %d\n", per_cu); per_cu = 1; }
        (void)hipGetLastError();
        grid = cus;
    }
    if (grid < 0) return;
    Args a{};
    for (int i = 0; i < 24; ++i) a.in[i] = (const float*)d_in[i];
    a.out = (float*)d_out; a.ws = (unsigned char*)d_ws;
#if MK_N_LAUNCHES == 1
    a.ph_lo = 0; a.ph_hi = N_PHASES;
#if USE_CG_SYNC
    void* kargs[] = {&a};
    hipError_t e = hipLaunchCooperativeKernel((const void*)mk_fwd, dim3(grid), dim3(NTHREADS), kargs, LDS_BYTES, stream);
    if (e != hipSuccess) fprintf(stderr, "kernel_launch: cooperative launch failed: %s (grid %d)\n", hipGetErrorString(e), grid);
#else
    if (hipMemsetAsync((char*)d_ws + WS_CTL, 0, CTL_ZERO_BYTES, stream) != hipSuccess) { fprintf(stderr, "kernel_launch: memset failed\n"); return; }
    hipLaunchKernelGGL(mk_fwd, dim3(grid), dim3(NTHREADS), LDS_BYTES, stream, a);
#endif
#else
    for (int p = 0; p < N_PHASES; ++p) { a.ph_lo = p; a.ph_hi = p + 1; hipLaunchKernelGGL(mk_fwd, dim3(grid), dim3(NTHREADS), LDS_BYTES, stream, a); }
#endif
}
```
